# Optimizing an MI355X kernel written in HIP

```python
import jax, jax.numpy as jnp
from jax import lax
import numpy as np

D_MODEL = 2048
BATCH = 32
SEQ = 256
DEPTH = 1
DEC_BATCH = 8
DEC_SEQ = 4096
PAST_LEN = 256

GRID_W = 64
MIX_W = D_MODEL
MLA_W = D_MODEL // 2
RET_W = MIX_W - MLA_W
MLA_NOPE = 128
ROPE_DIM = 64
QK_HEAD = MLA_NOPE + ROPE_DIM
MLA_V = 128
MLA_HEADS = MLA_W // MLA_V
Q_LORA = 384
KV_LORA = 256
RET_DV = 256
RET_DK = 128
RET_HEADS = RET_W // RET_DV
RET_QK = RET_HEADS * RET_DK
RET_CHUNK = 128
Q_BLOCK = 128
ROPE_BASE = 10000.0
EPS = 1e-6
IN_SIZES = (Q_LORA, KV_LORA, ROPE_DIM, MLA_W, RET_QK, RET_QK, RET_W, RET_W)
IN_COLS = Q_LORA + KV_LORA + ROPE_DIM + MLA_W + 2 * RET_QK + 2 * RET_W

kernel_name = 'hybrid_mla_retention_diffusion_step'


def rms_norm(x, w):
    xf = x.astype(jnp.float32)
    y = xf * lax.rsqrt(jnp.mean(xf * xf, axis=-1, keepdims=True) + EPS)
    return (y * w.astype(jnp.float32)).astype(x.dtype)


def rope_angles(pos, dim):
    half = dim // 2
    freqs = ROPE_BASE ** (-jnp.arange(half, dtype=jnp.float32) / half)
    return pos.astype(jnp.float32)[:, None] * freqs[None, :]


def apply_rotary(x, ang):
    cos = jnp.cos(ang)[None, :, None, :]
    sin = jnp.sin(ang)[None, :, None, :]
    xf = x.astype(jnp.float32)
    x1, x2 = jnp.split(xf, 2, axis=-1)
    return jnp.concatenate([x1 * cos - x2 * sin, x2 * cos + x1 * sin], axis=-1).astype(x.dtype)


def axial_rope_on_head(x, ang_row, ang_col):
    nope, rope = x[..., :MLA_NOPE], x[..., MLA_NOPE:]
    half = ROPE_DIM // 2
    rope = jnp.concatenate([apply_rotary(rope[..., :half], ang_row),
                            apply_rotary(rope[..., half:], ang_col)], axis=-1)
    return jnp.concatenate([nope, rope], axis=-1)


def adaln(x, mod, norm_w):
    shift, scale, gate = jnp.split(mod, 3, axis=-1)
    h = rms_norm(x, norm_w) * (1.0 + scale[:, None, :]) + shift[:, None, :]
    return h, gate[:, None, :]


def input_branches(h, w_in, q_norm_w, w_uq, qk_q_w, kv_norm_w):
    B, L, _ = h.shape
    offs = [int(v) for v in np.cumsum(IN_SIZES)[:-1]]
    q_lat, ckv_raw, k_rope, g_a, rq, rk, rv, g_b = jnp.split(h @ w_in, offs, axis=-1)
    q = (rms_norm(q_lat, q_norm_w) @ w_uq).reshape(B, L, MLA_HEADS, QK_HEAD)
    q = rms_norm(q, qk_q_w)
    ckv = rms_norm(ckv_raw, kv_norm_w)
    rq = rq.reshape(B, L, RET_HEADS, RET_DK)
    rk = rk.reshape(B, L, RET_HEADS, RET_DK) * (RET_DK ** -0.5)
    rv = rv.reshape(B, L, RET_HEADS, RET_DV)
    return q, ckv, k_rope, g_a, rq, rk, rv, g_b


def mla_keys_values(ckv, k_rope, w_uk, w_uv, qk_k_w):
    B, L, _ = ckv.shape
    k_nope = (ckv @ w_uk).reshape(B, L, MLA_HEADS, MLA_NOPE)
    k_r = jnp.broadcast_to(k_rope[:, :, None, :], (B, L, MLA_HEADS, ROPE_DIM))
    k = rms_norm(jnp.concatenate([k_nope, k_r], axis=-1), qk_k_w)
    v = (ckv @ w_uv).reshape(B, L, MLA_HEADS, MLA_V)
    return k, v


def block_attention(q, k, v):
    B, Lq, H, Dh = q.shape
    nblk = Lq // Q_BLOCK
    qb = q.reshape(B, nblk, Q_BLOCK, H, Dh).transpose(1, 0, 2, 3, 4)
    scale = Dh ** -0.5

    def one_block(qi):
        s = jnp.einsum('bqhd,bkhd->bhqk', qi, k).astype(jnp.float32) * scale
        p = jax.nn.softmax(s, axis=-1)
        return jnp.einsum('bhqk,bkhe->bqhe', p.astype(v.dtype), v)

    out = lax.map(one_block, qb)
    return out.transpose(1, 0, 2, 3, 4).reshape(B, Lq, H, v.shape[-1])


def retention_scan(q, k, v, log_gamma, s0, strict):
    B, L, H, DK = q.shape
    DV = v.shape[-1]
    C = RET_CHUNK
    n = L // C
    lg = log_gamma.astype(jnp.float32)
    idx = jnp.arange(C, dtype=jnp.float32)
    diff = idx[:, None] - idx[None, :]
    mask = (diff > 0) if strict else (diff >= 0)
    intra = jnp.where(mask[None], jnp.exp(jnp.where(mask, diff, 0.0)[None] * lg[:, None, None]), 0.0)
    q_dec = jnp.exp((idx[:, None] + 1.0) * lg[None, :])
    k_dec = jnp.exp((C - 1.0 - idx)[:, None] * lg[None, :])
    chunk_dec = jnp.exp(C * lg)

    def chunks(a):
        return a.reshape(B, n, C, H, a.shape[-1]).transpose(1, 0, 2, 3, 4).astype(jnp.float32)

    def step(S, xs):
        qc, kc, vc = xs
        s = jnp.einsum('bihd,bjhd->bhij', qc, kc) * intra[None]
        o = (jnp.einsum('bhij,bjhe->bihe', s, vc)
             + jnp.einsum('bihd,bhde->bihe', qc * q_dec[None, :, :, None], S))
        S = (S * chunk_dec[None, :, None, None]
             + jnp.einsum('bjhd,bjhe->bhde', kc * k_dec[None, :, :, None], vc))
        return S, o

    S, o = lax.scan(step, s0.astype(jnp.float32), (chunks(q), chunks(k), chunks(v)))
    o = o.transpose(1, 0, 2, 3, 4).reshape(B, L, H, DV).astype(v.dtype)
    return o, S


def bidir_retention(q, k, v, lg_f, lg_b, s_f, s_b):
    o_f, S_f = retention_scan(q, k, v, lg_f, s_f, False)
    o_b, S_b = retention_scan(jnp.flip(q, 1), jnp.flip(k, 1), jnp.flip(v, 1), lg_b, s_b, True)
    return o_f + jnp.flip(o_b, 1), S_f, S_b


def merge_output(attn, ret, g_a, g_b, gn_w, w_out):
    B, L = attn.shape[:2]
    ret = rms_norm(ret, gn_w)
    mix = jnp.concatenate([jax.nn.silu(g_a) * attn.reshape(B, L, MLA_W),
                           jax.nn.silu(g_b) * ret.reshape(B, L, RET_W)], axis=-1)
    return mix @ w_out


def setup_inputs(seed: int = 0) -> dict:
    key = jax.random.key(seed)
    ks = jax.random.split(key, 24)
    nrm = jax.random.normal
    f32 = jnp.float32
    a0 = jnp.asarray(np.log(-np.log1p(-2.0 ** (-5.0 - np.arange(RET_HEADS)))), dtype=f32)
    return {
        'x_prompt': nrm(ks[0], (BATCH, SEQ, D_MODEL), f32),
        'x_sample': nrm(ks[1], (DEC_BATCH, DEC_SEQ, D_MODEL), f32),
        'c': nrm(ks[2], (DEC_BATCH, D_MODEL), f32),
        'cache_mla_ckv': nrm(ks[3], (DEC_BATCH, DEPTH, PAST_LEN, KV_LORA), f32),
        'cache_mla_krope': nrm(ks[4], (DEC_BATCH, DEPTH, PAST_LEN, ROPE_DIM), f32),
        'state_ret_fwd': 0.1 * nrm(ks[5], (DEC_BATCH, DEPTH, RET_HEADS, RET_DK, RET_DV), f32),
        'state_ret_bwd': 0.1 * nrm(ks[6], (DEC_BATCH, DEPTH, RET_HEADS, RET_DK, RET_DV), f32),
        'c_ctx': nrm(ks[7], (D_MODEL,), f32),
        'norm_w': 1.0 + 0.01 * nrm(ks[8], (DEPTH, D_MODEL), f32),
        'w_mod': 0.5 * D_MODEL ** -0.5 * nrm(ks[9], (DEPTH, D_MODEL, 3 * D_MODEL), f32),
        'b_mod': 0.01 * nrm(ks[10], (DEPTH, 3 * D_MODEL), f32),
        'w_in': D_MODEL ** -0.5 * nrm(ks[11], (DEPTH, D_MODEL, IN_COLS), f32),
        'mla_q_norm_w': 1.0 + 0.01 * nrm(ks[12], (DEPTH, Q_LORA), f32),
        'mla_w_uq': Q_LORA ** -0.5 * nrm(ks[13], (DEPTH, Q_LORA, MLA_HEADS * QK_HEAD), f32),
        'mla_kv_norm_w': 1.0 + 0.01 * nrm(ks[14], (DEPTH, KV_LORA), f32),
        'mla_w_uk': KV_LORA ** -0.5 * nrm(ks[15], (DEPTH, KV_LORA, MLA_HEADS * MLA_NOPE), f32),
        'mla_w_uv': KV_LORA ** -0.5 * nrm(ks[16], (DEPTH, KV_LORA, MLA_W), f32),
        'mla_qk_q_w': 1.0 + 0.01 * nrm(ks[17], (DEPTH, QK_HEAD), f32),
        'mla_qk_k_w': 1.0 + 0.01 * nrm(ks[18], (DEPTH, QK_HEAD), f32),
        'ret_log_decay_fwd': a0[None, :] + 0.01 * nrm(ks[19], (DEPTH, RET_HEADS), f32),
        'ret_log_decay_bwd': a0[None, :] + 0.01 * nrm(ks[20], (DEPTH, RET_HEADS), f32),
        'ret_gn_w': 1.0 + 0.01 * nrm(ks[21], (DEPTH, RET_HEADS, RET_DV), f32),
        'w_out': MIX_W ** -0.5 * nrm(ks[22], (DEPTH, MIX_W, D_MODEL), f32),
    }


def reference(x_prompt, x_sample, c, cache_mla_ckv, cache_mla_krope, state_ret_fwd, state_ret_bwd,
              c_ctx, norm_w, w_mod, b_mod, w_in, mla_q_norm_w, mla_w_uq, mla_kv_norm_w, mla_w_uk,
              mla_w_uv, mla_qk_q_w, mla_qk_k_w, ret_log_decay_fwd, ret_log_decay_bwd, ret_gn_w, w_out):
    L_lat = x_sample.shape[1]
    ROWS = L_lat // GRID_W
    row = jnp.repeat(jnp.arange(ROWS), GRID_W)
    col = jnp.tile(jnp.arange(GRID_W), ROWS)
    ang_row = rope_angles(row, ROPE_DIM // 2)
    ang_col = rope_angles(col, ROPE_DIM // 2)
    ang_ret = rope_angles(jnp.arange(L_lat), RET_DK)

    xp = x_prompt
    Bp = x_prompt.shape[0]
    ckv_list, krope_list, sf_list, sb_list = [], [], [], []
    for l in range(DEPTH):
        lg_f = -jnp.exp(ret_log_decay_fwd[l].astype(jnp.float32))
        lg_b = -jnp.exp(ret_log_decay_bwd[l].astype(jnp.float32))
        mod = jax.nn.silu(c_ctx)[None, :] @ w_mod[l] + b_mod[l]
        h, gate = adaln(xp, mod, norm_w[l])
        q, ckv, k_rope, g_a, rq, rk, rv, g_b = input_branches(
            h, w_in[l], mla_q_norm_w[l], mla_w_uq[l], mla_qk_q_w[l], mla_kv_norm_w[l])
        k, v = mla_keys_values(ckv, k_rope, mla_w_uk[l], mla_w_uv[l], mla_qk_k_w[l])
        attn = block_attention(q, k, v)
        zero_state = jnp.zeros((Bp, RET_HEADS, RET_DK, RET_DV), jnp.float32)
        ret, s_f, s_b = bidir_retention(rq, rk, rv, lg_f, lg_b, zero_state, zero_state)
        xp = xp + gate * merge_output(attn, ret, g_a, g_b, ret_gn_w[l], w_out[l])
        ckv_list.append(ckv)
        krope_list.append(k_rope)
        sf_list.append(s_f)
        sb_list.append(s_b)

    xs = x_sample
    for l in range(DEPTH):
        lg_f = -jnp.exp(ret_log_decay_fwd[l].astype(jnp.float32))
        lg_b = -jnp.exp(ret_log_decay_bwd[l].astype(jnp.float32))
        mod = jax.nn.silu(c) @ w_mod[l] + b_mod[l]
        h, gate = adaln(xs, mod, norm_w[l])
        q, ckv, k_rope, g_a, rq, rk, rv, g_b = input_branches(
            h, w_in[l], mla_q_norm_w[l], mla_w_uq[l], mla_qk_q_w[l], mla_kv_norm_w[l])
        q = axial_rope_on_head(q, ang_row, ang_col)
        k_lat, v_lat = mla_keys_values(ckv, k_rope, mla_w_uk[l], mla_w_uv[l], mla_qk_k_w[l])
        k_lat = axial_rope_on_head(k_lat, ang_row, ang_col)
        k_ctx, v_ctx = mla_keys_values(cache_mla_ckv[:, l], cache_mla_krope[:, l],
                                       mla_w_uk[l], mla_w_uv[l], mla_qk_k_w[l])
        attn = block_attention(q, jnp.concatenate([k_lat, k_ctx], axis=1),
                               jnp.concatenate([v_lat, v_ctx], axis=1))
        rq = apply_rotary(rq, ang_ret)
        rk = apply_rotary(rk, ang_ret)
        ret, _, _ = bidir_retention(rq, rk, rv, lg_f, lg_b, state_ret_fwd[:, l], state_ret_bwd[:, l])
        xs = xs + gate * merge_output(attn, ret, g_a, g_b, ret_gn_w[l], w_out[l])

    new_ckv = jnp.stack(ckv_list, axis=1)
    new_krope = jnp.stack(krope_list, axis=1)
    new_sf = jnp.stack(sf_list, axis=1)
    new_sb = jnp.stack(sb_list, axis=1)
    return (xp, xs, new_ckv, new_krope, new_sf, new_sb)
```

```cpp
#include <hip/hip_runtime.h>
#include <hip/hip_cooperative_groups.h>
#include <cstdio>
#include <cstdint>
namespace cg = cooperative_groups;

typedef __attribute__((ext_vector_type(8))) short bf16x8;
typedef __attribute__((ext_vector_type(16))) float f32x16;
typedef __attribute__((ext_vector_type(2))) __bf16 bf2_t;
typedef unsigned short u16;
#define DI __device__ __forceinline__
#define MFMA(a, b, c) __builtin_amdgcn_mfma_f32_32x32x16_bf16((a), (b), (c), 0, 0, 0)

constexpr int D = 2048;
constexpr int NTP = 8192;
constexpr int NTS = 32768;
constexpr int NT = NTP + NTS;
constexpr int LP = 256, LS = 4096, NKS = 4352;
constexpr int PSW = 704;
constexpr float EPSF = 1e-6f;
constexpr float LOG2E = 1.4426950408889634f;

constexpr size_t al256(size_t x) { return (x + 255) & ~(size_t)255; }
constexpr size_t WS_MOD = 0;
constexpr size_t WS_BAR = al256(WS_MOD + 9 * 6144 * 4);
constexpr size_t WS_ROPE2D = al256(WS_BAR + 3456 * 4);
constexpr size_t WS_ROPER = al256(WS_ROPE2D + 64 * 16 * 8);
constexpr size_t WS_WIT = al256(WS_ROPER + (size_t)4096 * 64 * 8);
constexpr size_t WS_WUQT = al256(WS_WIT + (size_t)4864 * 2048 * 2);
constexpr size_t WS_WUKT = al256(WS_WUQT + (size_t)1536 * 384 * 2);
constexpr size_t WS_WUVT = al256(WS_WUKT + (size_t)1024 * 256 * 2);
constexpr size_t WS_WOT = al256(WS_WUVT + (size_t)1024 * 256 * 2);
constexpr size_t WS_CK = al256(WS_WOT + (size_t)2048 * 2048 * 2);
constexpr size_t WS_QF = al256(WS_CK + (size_t)2048 * 256 * 2);
constexpr size_t WS_G = al256(WS_QF + (size_t)NT * 8 * 4);
constexpr size_t WS_RQ = al256(WS_G + (size_t)NT * 2048 * 2);
constexpr size_t WS_RK = al256(WS_RQ + (size_t)NT * 512 * 2);
constexpr size_t WS_RKT = al256(WS_RK + (size_t)NT * 512 * 2);
constexpr size_t WS_RVT = al256(WS_RKT + (size_t)NT * 512 * 2);
constexpr size_t WS_REGD = al256(WS_RVT + (size_t)NT * 1024 * 2);
constexpr size_t WS_H = WS_REGD;
constexpr size_t WS_Q = WS_REGD;
constexpr size_t WS_K = al256(WS_Q + (size_t)NT * 8 * 192 * 2);
constexpr size_t K_ELEMS = (size_t)NTP * 8 * 192 + (size_t)8 * 8 * NKS * 192;
constexpr size_t WS_VT = al256(WS_K + K_ELEMS * 2);
constexpr size_t VT_ELEMS = (size_t)NTP * 8 * 128 + (size_t)8 * 8 * 128 * NKS;
constexpr size_t WS_REGE = al256(WS_VT + VT_ELEMS * 2);
constexpr size_t WS_PS = WS_REGE;
constexpr size_t WS_OF = WS_REGE;
constexpr size_t WS_OB = al256(WS_OF + (size_t)NT * 1024 * 2);
constexpr size_t WS_MIXA = al256(WS_OB + (size_t)NT * 1024 * 2);
constexpr size_t WS_MIXR = WS_REGD;
constexpr size_t WS_END = al256(WS_MIXA + (size_t)NT * 1024 * 2);

constexpr size_t Q_S_OFF = (size_t)NTP * 8 * 192;
constexpr size_t K_S_OFF = (size_t)NTP * 8 * 192;
constexpr size_t VT_S_OFF = (size_t)NTP * 8 * 128;
constexpr size_t RKT_S_OFF = (size_t)NTP * 512;
constexpr size_t RVT_S_OFF = (size_t)NTP * 1024;

constexpr size_t OUT_YP = 0;
constexpr size_t OUT_CKV = (size_t)NT * 2048;
constexpr size_t OUT_KROPE = OUT_CKV + (size_t)NTP * 256;
constexpr size_t OUT_SF = OUT_KROPE + (size_t)NTP * 64;
constexpr size_t OUT_SB = OUT_SF + (size_t)32 * 4 * 128 * 256;

constexpr int LDS_BYTES = 147456;

struct Params {
  const float* x_prompt; const float* x_sample; const float* c; const float* cache_ckv; const float* cache_krope;
  const float* st_fwd; const float* st_bwd; const float* c_ctx; const float* norm_w; const float* w_mod; const float* b_mod;
  const float* w_in; const float* q_norm_w; const float* w_uq; const float* kv_norm_w; const float* w_uk; const float* w_uv;
  const float* qk_q_w; const float* qk_k_w; const float* ld_fwd; const float* ld_bwd; const float* gn_w; const float* w_out;
  float* out; unsigned char* ws;
  int phase_lo, phase_hi;
};

DI unsigned pack2(float a, float b) { bf2_t v; v[0] = (__bf16)a; v[1] = (__bf16)b; return __builtin_bit_cast(unsigned, v); }
DI u16 f2bf(float a) { __bf16 v = (__bf16)a; return __builtin_bit_cast(u16, v); }
DI float bf2f(u16 u) { return __uint_as_float(((unsigned)u) << 16); }
DI float bflo(unsigned u) { return __uint_as_float(u << 16); }
DI float bfhi(unsigned u) { return __uint_as_float(u & 0xffff0000u); }
DI int crow(int reg, int hh) { return (reg & 3) + 8 * (reg >> 2) + 4 * hh; }
DI int launder_v(int x) { asm volatile("" : "+v"(x)); return x; }
DI int launder_s(int x) { asm volatile("" : "+s"(x)); return x; }
DI unsigned char* launder_p(unsigned char* x) { return x + (size_t)(unsigned)launder_s(0); }
DI float shx(float x, int k, int tid) { return __int_as_float(__builtin_amdgcn_ds_bpermute(((tid ^ k) & 63) << 2, __float_as_int(x))); }
DI float fexp2(float x) { return __builtin_amdgcn_exp2f(x); }
DI float silu(float x) { return x / (1.f + __expf(-x)); }
DI void zero16(f32x16& a) {
#pragma unroll
  for (int i = 0; i < 16; ++i) a[i] = 0.f;
}
DI void sincos_acc(double a, float& s, float& c) {
  double q = rint(a * 0.63661977236758134308);
  double r = a - q * 1.57079632679489661923;
  r = r - q * 6.123233995736766e-17;
  int qi = ((int)q) & 3;
  double r2 = r * r;
  double sn = r * (1.0 - r2 / 6.0 * (1.0 - r2 / 20.0 * (1.0 - r2 / 42.0 * (1.0 - r2 / 72.0 * (1.0 - r2 / 110.0 * (1.0 - r2 / 156.0))))));
  double cs = 1.0 - r2 / 2.0 * (1.0 - r2 / 12.0 * (1.0 - r2 / 30.0 * (1.0 - r2 / 56.0 * (1.0 - r2 / 90.0 * (1.0 - r2 / 132.0 * (1.0 - r2 / 182.0))))));
  double so, co;
  if (qi == 0) { so = sn; co = cs; } else if (qi == 1) { so = cs; co = -sn; } else if (qi == 2) { so = -sn; co = -cs; } else { so = -cs; co = sn; }
  s = (float)so; c = (float)co;
}

template <int RB, int LB, int WR, int WL>
DI void gemm_tile(f32x16 (&acc)[RB][LB], const u16* __restrict__ Rp, const u16* __restrict__ Rp2, int ksplit, int ldr,
                  const u16* __restrict__ Lp, int ldl, int K, char* smem, const int tid) {
  constexpr int NR = RB * WR * 32, NL = LB * WL * 32;
  constexpr int NCH = (NR + NL) / 64;
  constexpr int NCR = NR / 64;
  constexpr int STAGE = (NR + NL) * 144;
  static_assert(WR * WL == 8, "8 waves");
  static_assert(2 * STAGE <= LDS_BYTES, "lds");
  const int lane = tid & 63, wave = tid >> 6;
  const int wr = wave / WL, wl = wave % WL;
  const int r = lane & 31, hh = lane >> 5;
  const int lrow = tid >> 3, kc = tid & 7;
#pragma unroll
  for (int i = 0; i < RB; ++i)
#pragma unroll
    for (int j = 0; j < LB; ++j) zero16(acc[i][j]);
  uint4 pf0, pf1, pf2, pf3, pf4, pf5, pf6, pf7;
  static_assert(NCH <= 8, "NCH");
  const unsigned roff = (unsigned)lrow * (unsigned)ldr + kc * 8;
  const unsigned loff = (unsigned)lrow * (unsigned)ldl + kc * 8;
  char* const swbase = smem + lrow * 144 + kc * 16;
#define GT_GL1(c)                                                                                                   \
  if constexpr ((c) < NCH) {                                                                                        \
    if constexpr ((c) < NCR) pf##c = *(const uint4*)(rb_ + (roff + (unsigned)((c) * 64) * (unsigned)ldr));          \
    else pf##c = *(const uint4*)(lb_ + (loff + (unsigned)(((c) - NCR) * 64) * (unsigned)ldl));                      \
  }
#define GT_GLOAD(k0_)                                                                     \
  {                                                                                       \
    const int k0 = (k0_);                                                                 \
    const u16* rb_ = (k0 < ksplit) ? (Rp + k0) : (Rp2 + (k0 - ksplit));                   \
    const u16* lb_ = Lp + k0;                                                             \
    GT_GL1(0) GT_GL1(1) GT_GL1(2) GT_GL1(3) GT_GL1(4) GT_GL1(5) GT_GL1(6) GT_GL1(7)       \
  }
#define GT_SW1(c) if constexpr ((c) < NCH) *(uint4*)(sb_ + (c) * 64 * 144) = pf##c;
#define GT_SWRITE(st_)                                                                    \
  {                                                                                       \
    char* sb_ = swbase + (st_) * STAGE;                                                   \
    GT_SW1(0) GT_SW1(1) GT_SW1(2) GT_SW1(3) GT_SW1(4) GT_SW1(5) GT_SW1(6) GT_SW1(7)       \
  }
  int nk = K >> 6;
  asm volatile("" : "+s"(nk));
  GT_GLOAD(0);
  for (int kt = 0; kt < nk; ++kt) {
    GT_SWRITE(kt & 1);
    __syncthreads();
    const int ktn = (kt + 1 < nk) ? (kt + 1) : kt;
    GT_GLOAD(ktn << 6);
    const char* sR = smem + (kt & 1) * STAGE + (wr * RB * 32 + r) * 144 + hh * 16;
    const char* sL = smem + (kt & 1) * STAGE + (NR + wl * LB * 32 + r) * 144 + hh * 16;
#pragma unroll
    for (int s = 0; s < 4; ++s) {
      bf16x8 rf[RB], lf[LB];
#pragma unroll
      for (int i = 0; i < RB; ++i) rf[i] = *(const bf16x8*)(sR + i * 32 * 144 + s * 32);
#pragma unroll
      for (int j = 0; j < LB; ++j) lf[j] = *(const bf16x8*)(sL + j * 32 * 144 + s * 32);
#pragma unroll
      for (int i = 0; i < RB; ++i)
#pragma unroll
        for (int j = 0; j < LB; ++j) acc[i][j] = MFMA(rf[i], lf[j], acc[i][j]);
    }
  }
  __syncthreads();
}

typedef __attribute__((ext_vector_type(4))) float f32x4;
#define LAS __attribute__((address_space(3)))
DI int g8_lds_byte(int r, int c) {
  const int st = (r >> 4) * 2 + (c >> 5), rr = r & 15, cc = c & 31, ob = rr * 64 + cc * 2;
  return st * 1024 + (ob ^ (((ob >> 9) & 1) << 5));
}
DI void g8_stage_rc(int b, int& R, int& C) {
  const int st = b / 1024, sb = b % 1024, swz = sb ^ (((sb >> 9) & 1) << 5);
  R = (st >> 1) * 16 + swz / 64;
  C = (st & 1) * 32 + (swz % 64) / 2;
}
DI void gemm8p(f32x4 (&acc)[2][2][4][2], const u16* __restrict__ Ap, int lda, const u16* __restrict__ Bp, const u16* __restrict__ Bp2, int ksplit,
               int ldb, int nt_, char* smem, const int tid) {
  constexpr int HTB = 16384;
  const int nt = launder_s(nt_);
  LAS char* lds = (LAS char*)smem;
  const int wid = __builtin_amdgcn_readfirstlane(tid >> 6), lane = tid & 63, wr = wid >> 2, wc = wid & 3, fr = lane & 15, fq = lane >> 4;
  unsigned voffA[2], voffB[2];
#pragma unroll
  for (int i = 0; i < 2; ++i) {
    int R, C;
    g8_stage_rc(tid * 16 + i * 8192, R, C);
    voffA[i] = (unsigned)launder_v((R * lda + C) * 2);
    voffB[i] = (unsigned)launder_v((R * ldb + C) * 2);
  }
  const size_t hA = (size_t)128 * lda * 2, hB = (size_t)128 * ldb * 2;
  const unsigned ldsw = (unsigned)wid * 1024u;
  const int aoff = g8_lds_byte(wr * 64 + fr, fq * 8), boff = g8_lds_byte(wc * 32 + fr, fq * 8);
  const char* cA = (const char*)Ap;
#define G8_SA(b, h) (((b) * 2 + (h)) * HTB)
#define G8_SB(b, h) ((4 + (b) * 2 + (h)) * HTB)
#define G8_BK(kt) ((const char*)(((kt) * 64 < ksplit) ? (Bp + (kt) * 64) : (Bp2 + ((kt) * 64 - ksplit))))
#define G8_AK(kt) (cA + (size_t)(kt) * 128)
#define G8_STAGE(bufoff, gbase, voff)                                                                                         \
  do {                                                                                                                        \
    _Pragma("unroll") for (int _i = 0; _i < 2; ++_i) __builtin_amdgcn_global_load_lds(                                        \
        (const unsigned*)((const char*)(gbase) + (voff)[_i]), (LAS unsigned*)(lds + (bufoff) + ldsw + _i * 8192), 16, 0, 0);  \
  } while (0)
#define G8_LDA(dst, b, h)                                                                               \
  do {                                                                                                  \
    _Pragma("unroll") for (int m = 0; m < 4; ++m) _Pragma("unroll") for (int k = 0; k < 2; ++k)         \
        dst[m][k] = *(const LAS bf16x8*)(lds + G8_SA(b, h) + aoff + m * 2048 + k * 1024);               \
  } while (0)
#define G8_LDB(dst, b, h)                                                                               \
  do {                                                                                                  \
    _Pragma("unroll") for (int n = 0; n < 2; ++n) _Pragma("unroll") for (int k = 0; k < 2; ++k)         \
        dst[n][k] = *(const LAS bf16x8*)(lds + G8_SB(b, h) + boff + n * 2048 + k * 1024);               \
  } while (0)
#define G8_MMA(ai, bj, At_, Bt_)                                                                                              \
  do {                                                                                                                        \
    __builtin_amdgcn_s_setprio(1);                                                                                            \
    _Pragma("unroll") for (int m = 0; m < 4; ++m) _Pragma("unroll") for (int n = 0; n < 2; ++n) _Pragma("unroll") for (int k = 0; k < 2; ++k) \
        acc[ai][bj][m][n] = __builtin_amdgcn_mfma_f32_16x16x32_bf16(At_[m][k], Bt_[n][k], acc[ai][bj][m][n], 0, 0, 0);       \
    __builtin_amdgcn_s_setprio(0);                                                                                            \
  } while (0)
#define G8_WAIT_V(n) asm volatile("s_waitcnt vmcnt(" #n ")" ::: "memory")
#define G8_WAIT_L(n) asm volatile("s_waitcnt lgkmcnt(" #n ")" ::: "memory")
#define G8_BAR __builtin_amdgcn_s_barrier()
#define G8_SCHED __builtin_amdgcn_sched_barrier(0)
#pragma unroll
  for (int a = 0; a < 2; ++a)
#pragma unroll
    for (int b = 0; b < 2; ++b)
#pragma unroll
      for (int m = 0; m < 4; ++m)
#pragma unroll
        for (int n = 0; n < 2; ++n) acc[a][b][m][n] = (f32x4){0.f, 0.f, 0.f, 0.f};
  bf16x8 At[4][2], B0[2][2], B1[2][2];
  G8_WAIT_V(0);
  G8_STAGE(G8_SB(0, 0), G8_BK(0), voffB); G8_STAGE(G8_SA(0, 0), G8_AK(0), voffA);
  G8_STAGE(G8_SB(0, 1), G8_BK(0) + hB, voffB); G8_STAGE(G8_SA(0, 1), G8_AK(0) + hA, voffA);
  if (wr == 1) G8_BAR;
  G8_WAIT_V(4); G8_BAR;
  G8_STAGE(G8_SB(1, 0), G8_BK(1), voffB); G8_STAGE(G8_SA(1, 0), G8_AK(1), voffA); G8_STAGE(G8_SB(1, 1), G8_BK(1) + hB, voffB);
  G8_WAIT_V(6); G8_BAR;
  for (int t = 0; t < nt - 2; t += 2) {
    const char* a1 = G8_AK(t + 1); const char* a2 = G8_AK(t + 2); const char* a3 = G8_AK(t + 3);
    const char* b2 = G8_BK(t + 2); const char* b3 = G8_BK(t + 3);
    G8_LDB(B0, 0, 0); G8_SCHED; G8_LDA(At, 0, 0); G8_STAGE(G8_SA(1, 1), a1 + hA, voffA);
    G8_WAIT_L(8); G8_BAR; G8_WAIT_L(0); G8_MMA(0, 0, At, B0); G8_BAR; G8_SCHED;
    G8_LDB(B1, 0, 1); G8_STAGE(G8_SB(0, 0), b2, voffB);
    G8_BAR; G8_WAIT_L(0); G8_MMA(0, 1, At, B1); G8_BAR;
    G8_LDA(At, 0, 1); G8_STAGE(G8_SA(0, 0), a2, voffA);
    G8_BAR; G8_WAIT_L(0); G8_MMA(1, 0, At, B0); G8_BAR; G8_SCHED;
    G8_STAGE(G8_SB(0, 1), b2 + hB, voffB);
    G8_WAIT_V(6); G8_BAR; G8_MMA(1, 1, At, B1); G8_BAR;
    G8_LDB(B0, 1, 0); G8_SCHED; G8_LDA(At, 1, 0); G8_STAGE(G8_SA(0, 1), a2 + hA, voffA);
    G8_WAIT_L(8); G8_BAR; G8_WAIT_L(0); G8_MMA(0, 0, At, B0); G8_BAR; G8_SCHED;
    G8_LDB(B1, 1, 1); G8_STAGE(G8_SB(1, 0), b3, voffB);
    G8_BAR; G8_WAIT_L(0); G8_MMA(0, 1, At, B1); G8_BAR;
    G8_LDA(At, 1, 1); G8_STAGE(G8_SA(1, 0), a3, voffA);
    G8_BAR; G8_WAIT_L(0); G8_MMA(1, 0, At, B0); G8_BAR; G8_SCHED;
    G8_STAGE(G8_SB(1, 1), b3 + hB, voffB);
    G8_WAIT_V(6); G8_BAR; G8_MMA(1, 1, At, B1); G8_BAR;
  }
  {
    G8_LDB(B0, 0, 0); G8_LDA(At, 0, 0); G8_STAGE(G8_SA(1, 1), G8_AK(nt - 1) + hA, voffA);
    G8_BAR; G8_WAIT_L(0); G8_MMA(0, 0, At, B0); G8_BAR;
    G8_LDB(B1, 0, 1); G8_BAR; G8_WAIT_L(0); G8_MMA(0, 1, At, B1); G8_BAR;
    G8_LDA(At, 0, 1); G8_WAIT_V(4); G8_BAR; G8_WAIT_L(0); G8_MMA(1, 0, At, B0); G8_MMA(1, 1, At, B1); G8_BAR;
  }
  {
    G8_LDB(B0, 1, 0); G8_LDA(At, 1, 0); G8_WAIT_V(2); G8_BAR; G8_WAIT_L(0); G8_MMA(0, 0, At, B0); G8_BAR;
    G8_LDB(B1, 1, 1); G8_WAIT_V(0); G8_BAR; G8_WAIT_L(0); G8_MMA(0, 1, At, B1); G8_BAR;
    G8_LDA(At, 1, 1); G8_BAR; G8_WAIT_L(0); G8_MMA(1, 0, At, B0); G8_MMA(1, 1, At, B1); G8_BAR;
  }
  if (wr == 0) G8_BAR;
  __syncthreads();
}

DI void transpose_tile(const float* __restrict__ src, int N, int Kd, u16* __restrict__ dst, int k0, int n0, int nd0, char* smem, const int tid, const float* __restrict__ kscale = nullptr) {
  float* sT = (float*)smem;
  {
    const int kk = tid >> 3, seg = tid & 7;
    const float4* s4 = (const float4*)(src + (size_t)(k0 + kk) * N + n0 + seg * 8);
    float4 a = s4[0], b = s4[1];
    if (kscale) { const float ks = kscale[k0 + kk]; a.x *= ks; a.y *= ks; a.z *= ks; a.w *= ks; b.x *= ks; b.y *= ks; b.z *= ks; b.w *= ks; }
    float* d = sT + kk * 65 + seg * 8;
    d[0] = a.x; d[1] = a.y; d[2] = a.z; d[3] = a.w; d[4] = b.x; d[5] = b.y; d[6] = b.z; d[7] = b.w;
  }
  __syncthreads();
  {
    const int nn = tid >> 3, seg = tid & 7;
    float v[8];
#pragma unroll
    for (int j = 0; j < 8; ++j) v[j] = sT[(seg * 8 + j) * 65 + nn];
    uint4 o;
    o.x = pack2(v[0], v[1]); o.y = pack2(v[2], v[3]); o.z = pack2(v[4], v[5]); o.w = pack2(v[6], v[7]);
    *(uint4*)(dst + (size_t)(nd0 + nn) * Kd + k0 + seg * 8) = o;
  }
  __syncthreads();
}

DI void phase0(const int wave_s, const Params& p, char* smem, const bool skipmod) {
  unsigned char* ws = launder_p(p.ws);
  float* mod = (float*)(ws + WS_MOD);
  const int tid = launder_v(launder_s(wave_s) * 64 + (int)__builtin_amdgcn_mbcnt_hi(launder_s(-1), __builtin_amdgcn_mbcnt_lo(-1, 0)));
  constexpr int I_MOD = 384;
  constexpr int I_WIN = I_MOD + 2400;
  constexpr int I_WOUT = I_WIN + 1024;
  constexpr int I_WUQ = I_WOUT + 144;
  constexpr int I_WUK = I_WUQ + 64;
  constexpr int I_WUV = I_WUK + 64;
  constexpr int I_TAB = I_WUV + 514;
  constexpr int I_CK = I_TAB + 128;
  constexpr int I_PAD = I_CK + 32;
  for (int item = launder_s(blockIdx.x) + (skipmod ? 384 : 0); item < I_PAD; item += gridDim.x) {
    if (item < I_MOD) {
      const int ct = item % 24, kcn = item / 24;
      const int k0 = kcn * 128;
      float* sc = (float*)smem;
      for (int i = tid; i < 9 * 128; i += 512) {
        const int rr = i >> 7, kk = i & 127;
        const float v = (rr < 8) ? p.c[rr * 2048 + k0 + kk] : p.c_ctx[k0 + kk];
        sc[i] = silu(v);
      }
      __syncthreads();
      const int col = ct * 256 + (tid & 255), kh = tid >> 8;
      float a[9];
#pragma unroll
      for (int rr = 0; rr < 9; ++rr) a[rr] = 0.f;
      const float* wp = p.w_mod + (size_t)(k0 + kh * 64) * 6144 + col;
#pragma unroll 8
      for (int kk = 0; kk < 64; ++kk) {
        const float w = wp[(size_t)kk * 6144];
#pragma unroll
        for (int rr = 0; rr < 9; ++rr) a[rr] += sc[rr * 128 + kh * 64 + kk] * w;
      }
      const float bias = (kcn == 0 && kh == 0) ? p.b_mod[col] : 0.f;
#pragma unroll
      for (int rr = 0; rr < 9; ++rr) atomicAdd(mod + rr * 6144 + col, a[rr] + bias);
      __syncthreads();
    } else if (item < I_WIN) {
      const int t = item - I_MOD;
      const int kt = t % 32, ntile = t / 32;
      const int n0 = ntile * 64;
      const int nd0 = (n0 < 704) ? (n0 + 4096) : (n0 - 704);
      transpose_tile(p.w_in, 4800, 2048, (u16*)(ws + WS_WIT), kt * 64, n0, nd0, smem, tid);
    } else if (item < I_WOUT) {
      const int t = item - I_WIN;
      transpose_tile(p.w_out, 2048, 2048, (u16*)(ws + WS_WOT), (t % 32) * 64, (t / 32) * 64, (t / 32) * 64, smem, tid);
    } else if (item < I_WUQ) {
      const int t = item - I_WOUT;
      transpose_tile(p.w_uq, 1536, 384, (u16*)(ws + WS_WUQT), (t % 6) * 64, (t / 6) * 64, (t / 6) * 64, smem, tid, p.q_norm_w);
    } else if (item < I_WUK) {
      const int t = item - I_WUQ;
      transpose_tile(p.w_uk, 1024, 256, (u16*)(ws + WS_WUKT), (t % 4) * 64, (t / 4) * 64, (t / 4) * 64, smem, tid, p.kv_norm_w);
    } else if (item < I_WUV) {
      const int t = item - I_WUK;
      transpose_tile(p.w_uv, 1024, 256, (u16*)(ws + WS_WUVT), (t % 4) * 64, (t / 4) * 64, (t / 4) * 64, smem, tid, p.kv_norm_w);
    } else if (item < I_TAB) {
      const int t = item - I_WUV;
      if (t < 2) {
        const int idx = t * 512 + tid;
        const int pos = idx >> 4, i = idx & 15;
        const double fr = exp2(-(double)i / 16.0 * 13.287712379549449);
        float s, c;
        sincos_acc((double)pos * fr, s, c);
        ((float2*)(ws + WS_ROPE2D))[idx] = make_float2(c, s);
      } else {
        const int idx = (t - 2) * 512 + tid;
        const int pos = idx >> 6, i = idx & 63;
        const double fr = exp2(-(double)i / 64.0 * 13.287712379549449);
        float s, c;
        sincos_acc((double)pos * fr, s, c);
        ((float2*)(ws + WS_ROPER))[idx] = make_float2(c, s);
      }
    } else if (item < I_CK) {
      const int t = item - I_TAB;
      const size_t e0 = (size_t)t * 4096 + tid * 8;
      const float4* s4 = (const float4*)(p.cache_ckv + e0);
      float4 a = s4[0], b = s4[1];
      const float4 w0 = *(const float4*)(p.kv_norm_w + ((tid * 8) & 255)), w1 = *(const float4*)(p.kv_norm_w + ((tid * 8) & 255) + 4);
      uint4 o;
      o.x = pack2(a.x / w0.x, a.y / w0.y); o.y = pack2(a.z / w0.z, a.w / w0.w); o.z = pack2(b.x / w1.x, b.y / w1.y); o.w = pack2(b.z / w1.z, b.w / w1.w);
      *(uint4*)((u16*)(ws + WS_CK) + e0) = o;
    } else {
      const int t = item - I_CK;
      const size_t e0 = (size_t)4800 * 2048 + (size_t)t * 4096 + tid * 8;
      const unsigned z = (unsigned)launder_v(0);
      *(uint4*)((u16*)(ws + WS_WIT) + e0) = make_uint4(z, z, z, z);
    }
  }
}

DI void phase1(const int wave_s, const Params& p) {
  const float* mod = (const float*)(launder_p(p.ws) + WS_MOD);
  u16* H = (u16*)(launder_p(p.ws) + WS_H);
  const int tid = launder_v(launder_s(wave_s) * 64 + (int)__builtin_amdgcn_mbcnt_hi(launder_s(-1), __builtin_amdgcn_mbcnt_lo(-1, 0)));
  const int lane = tid & 63, wave = tid >> 6;
  for (int row = launder_s(blockIdx.x) * 8 + wave; row < NT; row += gridDim.x * 8) {
    const float* x = (row < NTP) ? (p.x_prompt + (size_t)row * D) : (p.x_sample + (size_t)(row - NTP) * D);
    const int mrow = (row < NTP) ? 8 : ((row - NTP) >> 12);
    const float* shift = mod + mrow * 6144;
    const float* scale = shift + 2048;
    float4 v[8];
    float ss = 0.f;
#pragma unroll
    for (int j = 0; j < 8; ++j) {
      v[j] = ((const float4*)x)[j * 64 + lane];
      ss += v[j].x * v[j].x + v[j].y * v[j].y + v[j].z * v[j].z + v[j].w * v[j].w;
    }
#pragma unroll
    for (int o = 32; o >= 1; o >>= 1) ss += shx(ss, o, tid);
    const float rstd = rsqrtf(ss * (1.f / 2048.f) + EPSF);
#pragma unroll
    for (int j = 0; j < 8; ++j) {
      const int c4 = j * 64 + lane;
      const float4 nw = ((const float4*)p.norm_w)[c4];
      const float4 sc = ((const float4*)scale)[c4];
      const float4 sh = ((const float4*)shift)[c4];
      const float a0 = v[j].x * rstd * nw.x * (1.f + sc.x) + sh.x;
      const float a1 = v[j].y * rstd * nw.y * (1.f + sc.y) + sh.y;
      const float a2 = v[j].z * rstd * nw.z * (1.f + sc.z) + sh.z;
      const float a3 = v[j].w * rstd * nw.w * (1.f + sc.w) + sh.w;
      uint2 o;
      o.x = pack2(a0, a1); o.y = pack2(a2, a3);
      *(uint2*)(H + (size_t)row * D + c4 * 4) = o;
    }
  }
}

DI void p2_tile(const int wave_s, const Params& p, char* smem, const int tok0, const int nt) {
  unsigned char* ws = launder_p(p.ws);
  const u16* H = (const u16*)(ws + WS_H);
  const u16* WiT = (const u16*)(ws + WS_WIT);
  const float2* ropeR = (const float2*)(ws + WS_ROPER);
  const int tid = launder_v(launder_s(wave_s) * 64 + (int)__builtin_amdgcn_mbcnt_hi(launder_s(-1), __builtin_amdgcn_mbcnt_lo(-1, 0))), lane = tid & 63, wave = tid >> 6;
  const int r = lane & 31, hh = lane >> 5;
  const int n0 = nt * 256;
  const bool sample = tok0 >= NTP;
  const int L = sample ? LS : LP;
  const int bb = sample ? ((tok0 - NTP) >> 12) : (tok0 >> 8);
  const int pos0 = sample ? ((tok0 - NTP) & 4095) : 0;
  f32x4 acc[2][2][4][2];
  gemm8p(acc, WiT + (size_t)n0 * D, D, H + (size_t)tok0 * D, H, 1 << 30, D, 32, smem, tid);
  const int wr = wave >> 2, wc = wave & 3, fr = lane & 15, fq = lane >> 4;
  const bool is_rk = (nt == 6 || nt == 7), is_rq = (nt == 4 || nt == 5);
  if (is_rk) {
#pragma unroll
    for (int a = 0; a < 2; ++a)
#pragma unroll
      for (int b = 0; b < 2; ++b)
#pragma unroll
        for (int m = 0; m < 4; ++m)
#pragma unroll
          for (int n = 0; n < 2; ++n) acc[a][b][m][n] *= 0.08838834764831845f;
  }
  if (nt == 18 && !sample && wr == 0) {
#pragma unroll
    for (int b = 0; b < 2; ++b)
#pragma unroll
      for (int n = 0; n < 2; ++n) {
        float* od = p.out + OUT_KROPE + (size_t)(tok0 + b * 128 + wc * 32 + n * 16 + fr) * 64 + fq * 4;
#pragma unroll
        for (int m = 0; m < 4; ++m) *(f32x4*)(od + m * 16) = acc[1][b][m][n];
      }
  }
#pragma unroll
  for (int b = 0; b < 2; ++b)
#pragma unroll
    for (int n = 0; n < 2; ++n) {
      char* d = smem + (b * 128 + wc * 32 + n * 16 + fr) * 528 + (wr * 64 + fq * 4) * 2;
#pragma unroll
      for (int a = 0; a < 2; ++a)
#pragma unroll
        for (int m = 0; m < 4; ++m) {
          uint2 o;
          o.x = pack2(acc[a][b][m][n][0], acc[a][b][m][n][1]); o.y = pack2(acc[a][b][m][n][2], acc[a][b][m][n][3]);
          *(uint2*)(d + (a * 128 + m * 16) * 2) = o;
        }
    }
  __syncthreads();
  if ((is_rk || is_rq) && sample) {
#pragma unroll 2
    for (int c = 0; c < 8; ++c) {
      const int u = tid + 512 * c;
      const int row = u >> 4, hp2 = (u >> 3) & 1, ch = u & 7;
      char* a = smem + row * 528 + (hp2 * 128 + ch * 8) * 2;
      const uint4 x1 = *(const uint4*)a, x2 = *(const uint4*)(a + 128);
      const float4* cp = (const float4*)(ropeR + (size_t)(pos0 + row) * 64 + ch * 8);
      const float4 t0 = cp[0], t1 = cp[1], t2 = cp[2], t3 = cp[3];
      const float cs[8] = {t0.x, t0.z, t1.x, t1.z, t2.x, t2.z, t3.x, t3.z};
      const float sn[8] = {t0.y, t0.w, t1.y, t1.w, t2.y, t2.w, t3.y, t3.w};
      const unsigned w1[4] = {x1.x, x1.y, x1.z, x1.w}, w2[4] = {x2.x, x2.y, x2.z, x2.w};
      unsigned o1[4], o2[4];
#pragma unroll
      for (int j = 0; j < 4; ++j) {
        const float a0 = bflo(w1[j]), a1 = bfhi(w1[j]), b0 = bflo(w2[j]), b1 = bfhi(w2[j]);
        o1[j] = pack2(a0 * cs[2 * j] - b0 * sn[2 * j], a1 * cs[2 * j + 1] - b1 * sn[2 * j + 1]);
        o2[j] = pack2(b0 * cs[2 * j] + a0 * sn[2 * j], b1 * cs[2 * j + 1] + a1 * sn[2 * j + 1]);
      }
      *(uint4*)a = make_uint4(o1[0], o1[1], o1[2], o1[3]);
      *(uint4*)(a + 128) = make_uint4(o2[0], o2[1], o2[2], o2[3]);
    }
    __syncthreads();
  }
  if (!(nt >= 8 && nt < 12)) {
    u16* dst; int ldo, c0, clim = 256;
    if (nt < 4) { dst = (u16*)(ws + WS_G); ldo = 2048; c0 = n0; }
    else if (nt < 6) { dst = (u16*)(ws + WS_RQ); ldo = 512; c0 = n0 - 1024; }
    else if (nt < 8) { dst = (u16*)(ws + WS_RK); ldo = 512; c0 = n0 - 1536; }
    else if (nt < 16) { dst = (u16*)(ws + WS_G); ldo = 2048; c0 = n0 - 2048; }
    else { dst = (u16*)(ws + WS_PS); ldo = PSW; c0 = n0 - 4096; clim = PSW - c0; }
    const int part = tid & 31, row0 = tid >> 5;
    if (part * 8 < clim) {
      u16* dp = dst + (size_t)(tok0 + row0) * ldo + c0 + part * 8;
      const char* sp = smem + row0 * 528 + part * 16;
#pragma unroll 2
      for (int c = 0; c < 16; ++c) *(uint4*)(dp + (size_t)c * 16 * ldo) = *(const uint4*)(sp + c * 16 * 528);
    }
  }
  if (nt >= 6 && nt < 12) {
    u16* T; size_t rowbase;
    if (nt < 8) { T = (u16*)(ws + WS_RKT) + (sample ? RKT_S_OFF : 0); rowbase = (size_t)bb * 512 + (nt - 6) * 256; }
    else { T = (u16*)(ws + WS_RVT) + (sample ? RVT_S_OFF : 0); rowbase = (size_t)bb * 1024 + (nt - 8) * 256; }
    const int f_lo = tid & 15, tg = (tid >> 4) & 31;
#pragma unroll 1
    for (int c = 0; c < 16; ++c) {
      const int f = c * 16 + f_lo;
      const char* sp = smem + (tg * 8) * 528 + f * 2;
      unsigned short v[8];
#pragma unroll
      for (int j = 0; j < 8; ++j) v[j] = *(const u16*)(sp + j * 528);
      uint4 o;
      o.x = v[0] | ((unsigned)v[1] << 16); o.y = v[2] | ((unsigned)v[3] << 16);
      o.z = v[4] | ((unsigned)v[5] << 16); o.w = v[6] | ((unsigned)v[7] << 16);
      *(uint4*)(T + (rowbase + f) * L + pos0 + tg * 8) = o;
    }
  }
  __syncthreads();
}

DI void phase2(const int wave_s, const Params& p, char* smem) {
  const int xcd = launder_s(blockIdx.x) & 7, bi = launder_s(blockIdx.x) >> 3, nb = gridDim.x >> 3;
  if (bi >= nb) return;
  for (int pos = xcd * 380 + bi; pos < (xcd + 1) * 380; pos += nb) {
    const int mg = pos / 152, pim = pos % 152;
    int ng, i;
    if (pim < 128) { ng = pim >> 5; i = pim & 31; } else { ng = 4; i = pim - 128; }
    const int mt = mg * 8 + (i & 7), nt = ng * 4 + (i >> 3);
    const int tok0 = mt * 256;
    p2_tile(wave_s, p, smem, tok0, nt);
  }
}

DI void p3_q8(const int wave_s, const Params& p, char* smem, const int tb, const int half) {
  unsigned char* ws = launder_p(p.ws);
  const u16* Ps = (const u16*)(ws + WS_PS);
  const u16* WuqT = (const u16*)(ws + WS_WUQT);
  u16* Qg = (u16*)(ws + WS_Q);
  float* QF = (float*)(ws + WS_QF);
  const float2* rope2d = (const float2*)(ws + WS_ROPE2D);
  const int tid = launder_v(launder_s(wave_s) * 64 + (int)__builtin_amdgcn_mbcnt_hi(launder_s(-1), __builtin_amdgcn_mbcnt_lo(-1, 0)));
  const int tok0 = tb * 256;
  const bool sample = tok0 >= NTP;
  const int bb = sample ? ((tok0 - NTP) >> 12) : (tok0 >> 8);
  const int pos0 = sample ? ((tok0 - NTP) & 4095) : 0;
  const int L = sample ? LS : LP;
  const size_t qoff = sample ? Q_S_OFF : 0;
  float* msq = (float*)(smem + 135168);
  float* ssq = msq + 256;
  {
    const int row = tid >> 1, hf = tid & 1;
    const u16* src = Ps + (size_t)(tok0 + row) * PSW + hf * 192;
    float ss = 0.f;
#pragma unroll 2
    for (int g = 0; g < 2; ++g) {
      uint4 v[12];
#pragma unroll
      for (int j = 0; j < 12; ++j) v[j] = *(const uint4*)(src + g * 96 + j * 8);
#pragma unroll
      for (int j = 0; j < 12; ++j) {
        const unsigned w[4] = {v[j].x, v[j].y, v[j].z, v[j].w};
#pragma unroll
        for (int q = 0; q < 4; ++q) { const float a = bflo(w[q]), b = bfhi(w[q]); ss += a * a + b * b; }
      }
    }
    ss += shx(ss, 1, tid);
    if (hf == 0) msq[row] = ss * (1.f / 384.f);
    ssq[tid] = 0.f;
    ssq[tid + 512] = 0.f;
  }
  __syncthreads();
  const float qscale = 0.07216878364870322f * LOG2E;
#pragma unroll 1
  for (int ft = 0; ft < 3; ++ft) {
    const int Fbase = half * 768 + ft * 256;
    f32x4 acc[2][2][4][2];
    gemm8p(acc, WuqT + (size_t)Fbase * 384, 384, Ps + (size_t)tok0 * PSW, Ps, 1 << 30, PSW, 6, smem, launder_v(tid));
    const int tid2 = launder_v(tid), lane = tid2 & 63, wave = __builtin_amdgcn_readfirstlane(tid2 >> 6);
    const int wr = wave >> 2, wc = wave & 3, fr = lane & 15, fq = lane >> 4;
#pragma unroll
    for (int ai = 0; ai < 2; ++ai) {
      const int g0 = Fbase + ai * 128 + wr * 64;
      const int hl = g0 / 192 - half * 4, d0 = g0 % 192;
#pragma unroll
      for (int bj = 0; bj < 2; ++bj)
#pragma unroll
        for (int n = 0; n < 2; ++n) {
          float s = 0.f;
#pragma unroll
          for (int m = 0; m < 4; ++m)
#pragma unroll
            for (int j = 0; j < 4; ++j) s += acc[ai][bj][m][n][j] * acc[ai][bj][m][n][j];
          s += shx(s, 16, tid2);
          s += shx(s, 32, tid2);
          if (fq == 0) atomicAdd(&ssq[(bj * 128 + wc * 32 + n * 16 + fr) * 4 + hl], s);
        }
#pragma unroll
      for (int m = 0; m < 4; ++m) {
        const f32x4 w4 = *(const f32x4*)(p.qk_q_w + d0 + m * 16 + fq * 4);
#pragma unroll
        for (int bj = 0; bj < 2; ++bj)
#pragma unroll
          for (int n = 0; n < 2; ++n) acc[ai][bj][m][n] *= w4;
      }
      if (sample && d0 == 128) {
#pragma unroll
        for (int bj = 0; bj < 2; ++bj)
#pragma unroll
          for (int n = 0; n < 2; ++n) {
            const int ps = pos0 + bj * 128 + wc * 32 + n * 16 + fr;
            const float4* cr = (const float4*)(rope2d + (ps >> 6) * 16 + fq * 4);
            const float4* cc = (const float4*)(rope2d + (ps & 63) * 16 + fq * 4);
            const float4 r0 = cr[0], r1 = cr[1], c0 = cc[0], c1 = cc[1];
            const float rc[4] = {r0.x, r0.z, r1.x, r1.z}, rs[4] = {r0.y, r0.w, r1.y, r1.w};
            const float ccs[4] = {c0.x, c0.z, c1.x, c1.z}, csn[4] = {c0.y, c0.w, c1.y, c1.w};
#pragma unroll
            for (int j = 0; j < 4; ++j) {
              const float x1 = acc[ai][bj][0][n][j], x2 = acc[ai][bj][1][n][j];
              acc[ai][bj][0][n][j] = x1 * rc[j] - x2 * rs[j];
              acc[ai][bj][1][n][j] = x2 * rc[j] + x1 * rs[j];
              const float y1 = acc[ai][bj][2][n][j], y2 = acc[ai][bj][3][n][j];
              acc[ai][bj][2][n][j] = y1 * ccs[j] - y2 * csn[j];
              acc[ai][bj][3][n][j] = y2 * ccs[j] + y1 * csn[j];
            }
          }
      }
#pragma unroll
      for (int bj = 0; bj < 2; ++bj)
#pragma unroll
        for (int n = 0; n < 2; ++n) {
          char* d = smem + (bj * 128 + wc * 32 + n * 16 + fr) * 528 + (ai * 128 + wr * 64 + fq * 4) * 2;
#pragma unroll
          for (int m = 0; m < 4; ++m) {
            const f32x4 v = acc[ai][bj][m][n] * qscale;
            uint2 o;
            o.x = pack2(v[0], v[1]); o.y = pack2(v[2], v[3]);
            *(uint2*)(d + m * 32) = o;
          }
        }
    }
    __syncthreads();
    {
      const int part = tid2 & 31, row0 = tid2 >> 5;
      const int F0 = Fbase + part * 8;
      const int head = F0 / 192, d = F0 % 192;
      u16* dst = Qg + qoff + ((size_t)(bb * 8 + head) * L + pos0 + row0) * 192 + d;
      const char* sp = smem + row0 * 528 + part * 16;
#pragma unroll 4
      for (int c = 0; c < 16; ++c) *(uint4*)(dst + (size_t)c * 16 * 192) = *(const uint4*)(sp + c * 16 * 528);
    }
    __syncthreads();
  }
  if (tid < 256) {
    const int tid2 = tid;
    const float e2 = EPSF * (msq[tid2] + EPSF);
    float4 o;
    o.x = rsqrtf(ssq[tid2 * 4 + 0] * (1.f / 192.f) + e2);
    o.y = rsqrtf(ssq[tid2 * 4 + 1] * (1.f / 192.f) + e2);
    o.z = rsqrtf(ssq[tid2 * 4 + 2] * (1.f / 192.f) + e2);
    o.w = rsqrtf(ssq[tid2 * 4 + 3] * (1.f / 192.f) + e2);
    *(float4*)(QF + (size_t)(tok0 + tid2) * 8 + half * 4) = o;
  }
  __syncthreads();
}

DI void p3_kv8(const int wave_s, const Params& p, char* smem, const int tbk, const bool isV) {
  unsigned char* ws = launder_p(p.ws);
  const u16* Ps = (const u16*)(ws + WS_PS);
  const u16* Wkv = (const u16*)(ws + WS_WUKT) + (isV ? (size_t)1024 * 256 : 0);
  u16* Kg = (u16*)(ws + WS_K);
  u16* Vtg = (u16*)(ws + WS_VT);
  const float2* rope2d = (const float2*)(ws + WS_ROPE2D);
  const int tid = launder_v(launder_s(wave_s) * 64 + (int)__builtin_amdgcn_mbcnt_hi(launder_s(-1), __builtin_amdgcn_mbcnt_lo(-1, 0)));
  const bool ctx = tbk >= 160;
  const int tok0 = ctx ? (tbk - 160) * 256 : tbk * 256;
  const bool sample = ctx || tok0 >= NTP;
  const bool dorope = sample && !ctx;
  int bb, pos0, key0, NK;
  size_t koff, voff;
  if (ctx) { bb = tbk - 160; pos0 = 0; key0 = 4096; NK = NKS; koff = K_S_OFF; voff = VT_S_OFF; }
  else if (sample) { bb = (tok0 - NTP) >> 12; pos0 = (tok0 - NTP) & 4095; key0 = pos0; NK = NKS; koff = K_S_OFF; voff = VT_S_OFF; }
  else { bb = tok0 >> 8; pos0 = 0; key0 = 0; NK = LP; koff = 0; voff = 0; }
  const u16* Bsrc = ctx ? ((const u16*)(ws + WS_CK) + (size_t)tok0 * 256) : (Ps + (size_t)tok0 * PSW + 384);
  const int ldb = ctx ? 256 : PSW;
  float* rstdc = (float*)(smem + 135168);
  float* krss = rstdc + 256;
  float* ssqk = krss + 256;
  {
    const int row = tid >> 1, hf = tid & 1;
    if (!ctx) {
      const u16* src = Ps + (size_t)(tok0 + row) * PSW + 384 + hf * 128;
      uint4 v[16];
      float ss = 0.f;
#pragma unroll
      for (int j = 0; j < 16; ++j) v[j] = *(const uint4*)(src + j * 8);
#pragma unroll
      for (int j = 0; j < 16; ++j) {
        const unsigned w[4] = {v[j].x, v[j].y, v[j].z, v[j].w};
#pragma unroll
        for (int q = 0; q < 4; ++q) { const float a = bflo(w[q]), b = bfhi(w[q]); ss += a * a + b * b; }
      }
      ss += shx(ss, 1, tid);
      const float rstd = rsqrtf(ss * (1.f / 256.f) + EPSF);
      if (hf == 0) rstdc[row] = rstd;
      if (!isV && tok0 < NTP) {
        float* od = p.out + OUT_CKV + (size_t)(tok0 + row) * 256 + hf * 128;
#pragma unroll
        for (int j = 0; j < 16; ++j) {
          const float4 n0 = *(const float4*)(p.kv_norm_w + hf * 128 + j * 8), n1 = *(const float4*)(p.kv_norm_w + hf * 128 + j * 8 + 4);
          *(float4*)(od + j * 8) = make_float4(bflo(v[j].x) * rstd * n0.x, bfhi(v[j].x) * rstd * n0.y, bflo(v[j].y) * rstd * n0.z, bfhi(v[j].y) * rstd * n0.w);
          *(float4*)(od + j * 8 + 4) = make_float4(bflo(v[j].z) * rstd * n1.x, bfhi(v[j].z) * rstd * n1.y, bflo(v[j].w) * rstd * n1.z, bfhi(v[j].w) * rstd * n1.w);
        }
      }
      if (!isV) {
        const u16* ks = Ps + (size_t)(tok0 + row) * PSW + 640 + hf * 32;
        float s2 = 0.f;
#pragma unroll
        for (int j = 0; j < 4; ++j) {
          const uint4 a = *(const uint4*)(ks + j * 8);
          const unsigned w[4] = {a.x, a.y, a.z, a.w};
#pragma unroll
          for (int q = 0; q < 4; ++q) { const float x = bflo(w[q]), y = bfhi(w[q]); s2 += x * x + y * y; }
        }
        s2 += shx(s2, 1, tid);
        if (hf == 0) krss[row] = s2;
      }
    } else {
      if (hf == 0) rstdc[row] = 1.f;
      if (!isV) {
        const float* ks = p.cache_krope + (size_t)(tok0 + row) * 64 + hf * 32;
        float s2 = 0.f;
#pragma unroll
        for (int j = 0; j < 8; ++j) {
          const float4 a = *(const float4*)(ks + j * 4);
          const float x0 = bf2f(f2bf(a.x)), x1 = bf2f(f2bf(a.y)), x2 = bf2f(f2bf(a.z)), x3 = bf2f(f2bf(a.w));
          s2 += x0 * x0 + x1 * x1 + x2 * x2 + x3 * x3;
        }
        s2 += shx(s2, 1, tid);
        if (hf == 0) krss[row] = s2;
      }
    }
#pragma unroll
    for (int j = 0; j < 4; ++j) ssqk[tid + 512 * j] = 0.f;
  }
  __syncthreads();
#pragma unroll 1
  for (int ft = 0; ft < 4; ++ft) {
    f32x4 acc[2][2][4][2];
    gemm8p(acc, Wkv + (size_t)ft * 256 * 256, 256, Bsrc, Bsrc, 1 << 30, ldb, 4, smem, launder_v(tid));
    const int tid2 = launder_v(tid), lane = tid2 & 63, wave = __builtin_amdgcn_readfirstlane(tid2 >> 6);
    const int wr = wave >> 2, wc = wave & 3, fr = lane & 15, fq = lane >> 4;
    if (!isV) {
#pragma unroll
      for (int ai = 0; ai < 2; ++ai) {
#pragma unroll
        for (int bj = 0; bj < 2; ++bj)
#pragma unroll
          for (int n = 0; n < 2; ++n) {
            float s = 0.f;
#pragma unroll
            for (int m = 0; m < 4; ++m)
#pragma unroll
              for (int j = 0; j < 4; ++j) s += acc[ai][bj][m][n][j] * acc[ai][bj][m][n][j];
            s += shx(s, 16, tid2);
            s += shx(s, 32, tid2);
            if (fq == 0) atomicAdd(&ssqk[(bj * 128 + wc * 32 + n * 16 + fr) * 8 + ft * 2 + ai], s);
          }
#pragma unroll
        for (int m = 0; m < 4; ++m) {
          const f32x4 w4 = *(const f32x4*)(p.qk_k_w + wr * 64 + m * 16 + fq * 4);
#pragma unroll
          for (int bj = 0; bj < 2; ++bj)
#pragma unroll
            for (int n = 0; n < 2; ++n) acc[ai][bj][m][n] *= w4;
        }
      }
    } else {
#pragma unroll
      for (int bj = 0; bj < 2; ++bj)
#pragma unroll
        for (int n = 0; n < 2; ++n) {
          const float rc = rstdc[bj * 128 + wc * 32 + n * 16 + fr];
#pragma unroll
          for (int ai = 0; ai < 2; ++ai)
#pragma unroll
            for (int m = 0; m < 4; ++m) acc[ai][bj][m][n] *= rc;
        }
    }
#pragma unroll
    for (int bj = 0; bj < 2; ++bj)
#pragma unroll
      for (int n = 0; n < 2; ++n) {
        char* d = smem + (bj * 128 + wc * 32 + n * 16 + fr) * 528 + (wr * 64 + fq * 4) * 2;
#pragma unroll
        for (int ai = 0; ai < 2; ++ai)
#pragma unroll
          for (int m = 0; m < 4; ++m) {
            uint2 o;
            o.x = pack2(acc[ai][bj][m][n][0], acc[ai][bj][m][n][1]); o.y = pack2(acc[ai][bj][m][n][2], acc[ai][bj][m][n][3]);
            *(uint2*)(d + (ai * 128 + m * 16) * 2) = o;
          }
      }
    __syncthreads();
    if (!isV) {
      {
        const int part = tid2 & 31, row0 = tid2 >> 5;
        const int ai = part >> 4, d = (part & 15) * 8;
        u16* dst = Kg + koff + ((size_t)(bb * 8 + ft * 2 + ai) * NK + key0 + row0) * 192 + d;
#pragma unroll 4
        for (int c = 0; c < 16; ++c) {
          const int row = row0 + c * 16;
          const float rc = rstdc[row];
          const float rinv = rsqrtf((rc * rc * ssqk[row * 8 + ft * 2 + ai] + krss[row]) * (1.f / 192.f) + EPSF);
          const float f = rc * rinv;
          const uint4 v = *(const uint4*)(smem + row * 528 + part * 16);
          uint4 o;
          o.x = pack2(bflo(v.x) * f, bfhi(v.x) * f); o.y = pack2(bflo(v.y) * f, bfhi(v.y) * f);
          o.z = pack2(bflo(v.z) * f, bfhi(v.z) * f); o.w = pack2(bflo(v.w) * f, bfhi(v.w) * f);
          *(uint4*)(dst + (size_t)c * 16 * 192) = o;
        }
      }
#pragma unroll 2
      for (int c = 0; c < 4; ++c) {
        const int u = tid2 + 512 * c;
        const int row = u >> 3, ai = (u >> 2) & 1, q = u & 3;
        const int axis = q >> 1, jb = (q & 1) * 8;
        float x1[8], x2[8];
        if (ctx) {
          const float* ks = p.cache_krope + (size_t)(tok0 + row) * 64 + axis * 32 + jb;
          const float4 a0 = *(const float4*)ks, a1 = *(const float4*)(ks + 4), b0 = *(const float4*)(ks + 16), b1 = *(const float4*)(ks + 20);
          x1[0] = a0.x; x1[1] = a0.y; x1[2] = a0.z; x1[3] = a0.w; x1[4] = a1.x; x1[5] = a1.y; x1[6] = a1.z; x1[7] = a1.w;
          x2[0] = b0.x; x2[1] = b0.y; x2[2] = b0.z; x2[3] = b0.w; x2[4] = b1.x; x2[5] = b1.y; x2[6] = b1.z; x2[7] = b1.w;
#pragma unroll
          for (int j = 0; j < 8; ++j) { x1[j] = bf2f(f2bf(x1[j])); x2[j] = bf2f(f2bf(x2[j])); }
        } else {
          const u16* ks = Ps + (size_t)(tok0 + row) * PSW + 640 + axis * 32 + jb;
          const uint4 a = *(const uint4*)ks, b = *(const uint4*)(ks + 16);
          x1[0] = bflo(a.x); x1[1] = bfhi(a.x); x1[2] = bflo(a.y); x1[3] = bfhi(a.y); x1[4] = bflo(a.z); x1[5] = bfhi(a.z); x1[6] = bflo(a.w); x1[7] = bfhi(a.w);
          x2[0] = bflo(b.x); x2[1] = bfhi(b.x); x2[2] = bflo(b.y); x2[3] = bfhi(b.y); x2[4] = bflo(b.z); x2[5] = bfhi(b.z); x2[6] = bflo(b.w); x2[7] = bfhi(b.w);
        }
        const float rc = rstdc[row];
        const float rinv = rsqrtf((rc * rc * ssqk[row * 8 + ft * 2 + ai] + krss[row]) * (1.f / 192.f) + EPSF);
        const float* wp = p.qk_k_w + 128 + axis * 32 + jb;
        const float4 wa0 = *(const float4*)wp, wa1 = *(const float4*)(wp + 4), wb0 = *(const float4*)(wp + 16), wb1 = *(const float4*)(wp + 20);
        const float wa[8] = {wa0.x, wa0.y, wa0.z, wa0.w, wa1.x, wa1.y, wa1.z, wa1.w};
        const float wb[8] = {wb0.x, wb0.y, wb0.z, wb0.w, wb1.x, wb1.y, wb1.z, wb1.w};
        float cs[8], sn[8];
        if (dorope) {
          const int ps = pos0 + row;
          const int pp = axis ? (ps & 63) : (ps >> 6);
          const float4* cp = (const float4*)(rope2d + pp * 16 + jb);
          const float4 t0 = cp[0], t1 = cp[1], t2 = cp[2], t3 = cp[3];
          cs[0] = t0.x; cs[1] = t0.z; cs[2] = t1.x; cs[3] = t1.z; cs[4] = t2.x; cs[5] = t2.z; cs[6] = t3.x; cs[7] = t3.z;
          sn[0] = t0.y; sn[1] = t0.w; sn[2] = t1.y; sn[3] = t1.w; sn[4] = t2.y; sn[5] = t2.w; sn[6] = t3.y; sn[7] = t3.w;
        } else {
#pragma unroll
          for (int j = 0; j < 8; ++j) { cs[j] = 1.f; sn[j] = 0.f; }
        }
        float o1[8], o2[8];
#pragma unroll
        for (int j = 0; j < 8; ++j) {
          const float a = x1[j] * wa[j] * rinv, b = x2[j] * wb[j] * rinv;
          o1[j] = a * cs[j] - b * sn[j];
          o2[j] = b * cs[j] + a * sn[j];
        }
        u16* dst = Kg + koff + ((size_t)(bb * 8 + ft * 2 + ai) * NK + key0 + row) * 192 + 128 + axis * 32 + jb;
        *(uint4*)dst = make_uint4(pack2(o1[0], o1[1]), pack2(o1[2], o1[3]), pack2(o1[4], o1[5]), pack2(o1[6], o1[7]));
        *(uint4*)(dst + 16) = make_uint4(pack2(o2[0], o2[1]), pack2(o2[2], o2[3]), pack2(o2[4], o2[5]), pack2(o2[6], o2[7]));
      }
    } else {
      u16* T = Vtg + voff + ((size_t)bb * 1024 + ft * 256) * NK + key0;
      const int f_lo = tid2 & 15, tg = tid2 >> 4;
#pragma unroll 1
      for (int c = 0; c < 16; ++c) {
        const int f = c * 16 + f_lo;
        const char* sp = smem + ((tg >> 1) * 16 + 4 * (tg & 1)) * 528 + f * 2;
        unsigned short v[8];
#pragma unroll
        for (int j = 0; j < 8; ++j) v[j] = *(const u16*)(sp + ((j & 3) + 8 * (j >> 2)) * 528);
        uint4 o;
        o.x = v[0] | ((unsigned)v[1] << 16); o.y = v[2] | ((unsigned)v[3] << 16);
        o.z = v[4] | ((unsigned)v[5] << 16); o.w = v[6] | ((unsigned)v[7] << 16);
        *(uint4*)(T + (size_t)f * NK + tg * 8) = o;
      }
    }
    __syncthreads();
  }
}

DI void phase3(const int wave_s, const Params& p, char* smem) {
  for (int item = launder_s(blockIdx.x); item < 656; item += gridDim.x) {
    if (item < 320) p3_q8(wave_s, p, smem, item >> 1, item & 1);
    else if (item < 488) p3_kv8(wave_s, p, smem, item - 320, false);
    else p3_kv8(wave_s, p, smem, item - 488, true);
  }
}

DI void phase_attn(const int wave_s, const Params& p, char* smem) {
  unsigned char* ws = launder_p(p.ws);
  const u16* Qg = (const u16*)(ws + WS_Q);
  const u16* Kg = (const u16*)(ws + WS_K);
  const u16* Vtg = (const u16*)(ws + WS_VT);
  const u16* G = (const u16*)(ws + WS_G);
  u16* mixA = (u16*)(ws + WS_MIXA);
  const int tid = launder_v(launder_s(wave_s) * 64 + (int)__builtin_amdgcn_mbcnt_hi(launder_s(-1), __builtin_amdgcn_mbcnt_lo(-1, 0))), lane = tid & 63, wave = __builtin_amdgcn_readfirstlane(tid >> 6);
  const int r = lane & 31, hh = lane >> 5;
  constexpr int KT_B = 64 * 400, VT_B = 128 * 144, ST_B = KT_B + VT_B;
  const int nblk = gridDim.x;
  for (int it = launder_s(blockIdx.x); it < 1024 + 256; it += nblk) {
    int bh, qb, L, NK, tokbase;
    const u16 *Qb, *Kb, *Vb;
    if (it < 1024) {
      int item = it;
      if (nblk == 256) { const int xcd = it & 7, i = (it >> 3) & 31, j = it >> 8; item = ((j * 16 + xcd * 2 + (i >> 4)) << 4) | (i & 15); }
      bh = item >> 4; qb = item & 15; L = LS; NK = NKS;
      Qb = Qg + Q_S_OFF + (size_t)bh * LS * 192; Kb = Kg + K_S_OFF + (size_t)bh * NKS * 192; Vb = Vtg + VT_S_OFF + (size_t)bh * 128 * NKS;
      tokbase = NTP + (bh >> 3) * LS;
    } else {
      bh = it - 1024; qb = 0; L = LP; NK = LP;
      Qb = Qg + (size_t)bh * LP * 192; Kb = Kg + (size_t)bh * LP * 192; Vb = Vtg + (size_t)bh * 128 * LP;
      tokbase = (bh >> 3) * LP;
    }
    const int h = bh & 7;
    const int qrow = qb * 256 + wave * 32 + r;
    uint4 pkA0, pkA1, pkA2, pvA0, pvA1, pkB0, pkB1, pkB2, pvB0, pvB1;
    const int vrow0 = tid >> 3, vpart = tid & 7;
#define ATT_GLOAD(S, t_)                                                                   \
  {                                                                                         \
    const u16* ksrc = Kb + (size_t)(t_) * 64 * 192 + (size_t)tid * 8;                       \
    pk##S##0 = *(const uint4*)(ksrc);                                                       \
    pk##S##1 = *(const uint4*)(ksrc + 512 * 8);                                             \
    pk##S##2 = *(const uint4*)(ksrc + 1024 * 8);                                            \
    const u16* vsrc = Vb + (size_t)vrow0 * NK + (t_) * 64 + vpart * 8;                      \
    pv##S##0 = *(const uint4*)(vsrc);                                                       \
    pv##S##1 = *(const uint4*)(vsrc + (size_t)64 * NK);                                     \
  }
#define ATT_SWRITE(S, st_)                                                                 \
  {                                                                                         \
    char* sb = smem + (st_) * ST_B;                                                         \
    *(uint4*)(sb + (tid / 24) * 400 + (tid % 24) * 16) = pk##S##0;                          \
    *(uint4*)(sb + ((tid + 512) / 24) * 400 + ((tid + 512) % 24) * 16) = pk##S##1;          \
    *(uint4*)(sb + ((tid + 1024) / 24) * 400 + ((tid + 1024) % 24) * 16) = pk##S##2;        \
    char* d = sb + KT_B + vrow0 * 144 + vpart * 16;                                         \
    *(uint4*)d = pv##S##0;                                                                  \
    *(uint4*)(d + 64 * 144) = pv##S##1;                                                     \
  }
    const int ntiles = NK >> 6;
    ATT_GLOAD(A, 0);
    ATT_GLOAD(B, 1);
    bf16x8 qf[12];
    {
      const u16* qp = Qb + (size_t)qrow * 192 + hh * 8;
#pragma unroll
      for (int s = 0; s < 12; ++s) qf[s] = *(const bf16x8*)(qp + s * 16);
      const float rq = ((const float*)(ws + WS_QF))[((size_t)tokbase + qrow) * 8 + h];
#pragma unroll
      for (int s = 0; s < 12; ++s) {
        const uint4 u = __builtin_bit_cast(uint4, qf[s]);
        uint4 o;
        o.x = pack2(bflo(u.x) * rq, bfhi(u.x) * rq); o.y = pack2(bflo(u.y) * rq, bfhi(u.y) * rq);
        o.z = pack2(bflo(u.z) * rq, bfhi(u.z) * rq); o.w = pack2(bflo(u.w) * rq, bfhi(u.w) * rq);
        qf[s] = __builtin_bit_cast(bf16x8, o);
      }
    }
    f32x16 ot[4];
#pragma unroll
    for (int e = 0; e < 4; ++e) zero16(ot[e]);
    float m = -1e30f, l = 0.f;
    ATT_SWRITE(A, 0);
    __syncthreads();
    if (2 < ntiles) ATT_GLOAD(A, 2);
    if (wave >= 4) __builtin_amdgcn_s_setprio(1);
    for (int t2 = 0; t2 < ntiles; t2 += 2) {
      {
        const int t = t2;
        ATT_SWRITE(B, 1);
        if (t + 3 < ntiles) ATT_GLOAD(B, t + 3);
      const char* sK = smem + (t & 1) * ST_B + r * 400 + hh * 16;
      const char* sV = smem + (t & 1) * ST_B + KT_B + r * 144 + hh * 16;
      f32x16 st[2];
      zero16(st[0]);
      zero16(st[1]);
#pragma unroll
      for (int s = 0; s < 12; ++s) {
        const bf16x8 k0 = *(const bf16x8*)(sK + s * 32);
        const bf16x8 k1 = *(const bf16x8*)(sK + 32 * 400 + s * 32);
        st[0] = MFMA(k0, qf[s], st[0]);
        st[1] = MFMA(k1, qf[s], st[1]);
      }
      float mx = st[0][0];
#pragma unroll
      for (int g = 1; g < 16; ++g) mx = fmaxf(mx, st[0][g]);
#pragma unroll
      for (int g = 0; g < 16; ++g) mx = fmaxf(mx, st[1][g]);
      mx = fmaxf(mx, shx(mx, 32, tid));
      if (__builtin_amdgcn_ballot_w64(mx > m + 11.5f) != 0ull) {
        const float mnew = fmaxf(m, mx);
        const float alpha = fexp2(m - mnew);
        m = mnew;
        l *= alpha;
#pragma unroll
        for (int e = 0; e < 4; ++e)
#pragma unroll
          for (int g = 0; g < 16; ++g) ot[e][g] *= alpha;
      }
      float psum = 0.f;
#pragma unroll
      for (int b2 = 0; b2 < 2; ++b2)
#pragma unroll
        for (int g = 0; g < 16; ++g) {
          const float e = fexp2(st[b2][g] - m);
          st[b2][g] = e;
          psum += e;
        }
      l += psum;
#pragma unroll
      for (int s4 = 0; s4 < 4; ++s4) {
        const int mb = s4 >> 1, sub = s4 & 1;
        uint4 pp;
        pp.x = pack2(st[mb][8 * sub + 0], st[mb][8 * sub + 1]);
        pp.y = pack2(st[mb][8 * sub + 2], st[mb][8 * sub + 3]);
        pp.z = pack2(st[mb][8 * sub + 4], st[mb][8 * sub + 5]);
        pp.w = pack2(st[mb][8 * sub + 6], st[mb][8 * sub + 7]);
        const bf16x8 pfrag = __builtin_bit_cast(bf16x8, pp);
#pragma unroll
        for (int eb = 0; eb < 4; ++eb) {
          const uint4 vv = *(const uint4*)(sV + eb * 32 * 144 + s4 * 32);
          ot[eb] = MFMA(__builtin_bit_cast(bf16x8, vv), pfrag, ot[eb]);
        }
      }
        __syncthreads();
      }
      {
        const int t = t2 + 1;
        if (t + 1 < ntiles) ATT_SWRITE(A, 0);
        if (t + 3 < ntiles) ATT_GLOAD(A, t + 3);
      const char* sK = smem + (t & 1) * ST_B + r * 400 + hh * 16;
      const char* sV = smem + (t & 1) * ST_B + KT_B + r * 144 + hh * 16;
      f32x16 st[2];
      zero16(st[0]);
      zero16(st[1]);
#pragma unroll
      for (int s = 0; s < 12; ++s) {
        const bf16x8 k0 = *(const bf16x8*)(sK + s * 32);
        const bf16x8 k1 = *(const bf16x8*)(sK + 32 * 400 + s * 32);
        st[0] = MFMA(k0, qf[s], st[0]);
        st[1] = MFMA(k1, qf[s], st[1]);
      }
      float mx = st[0][0];
#pragma unroll
      for (int g = 1; g < 16; ++g) mx = fmaxf(mx, st[0][g]);
#pragma unroll
      for (int g = 0; g < 16; ++g) mx = fmaxf(mx, st[1][g]);
      mx = fmaxf(mx, shx(mx, 32, tid));
      if (__builtin_amdgcn_ballot_w64(mx > m + 11.5f) != 0ull) {
        const float mnew = fmaxf(m, mx);
        const float alpha = fexp2(m - mnew);
        m = mnew;
        l *= alpha;
#pragma unroll
        for (int e = 0; e < 4; ++e)
#pragma unroll
          for (int g = 0; g < 16; ++g) ot[e][g] *= alpha;
      }
      float psum = 0.f;
#pragma unroll
      for (int b2 = 0; b2 < 2; ++b2)
#pragma unroll
        for (int g = 0; g < 16; ++g) {
          const float e = fexp2(st[b2][g] - m);
          st[b2][g] = e;
          psum += e;
        }
      l += psum;
#pragma unroll
      for (int s4 = 0; s4 < 4; ++s4) {
        const int mb = s4 >> 1, sub = s4 & 1;
        uint4 pp;
        pp.x = pack2(st[mb][8 * sub + 0], st[mb][8 * sub + 1]);
        pp.y = pack2(st[mb][8 * sub + 2], st[mb][8 * sub + 3]);
        pp.z = pack2(st[mb][8 * sub + 4], st[mb][8 * sub + 5]);
        pp.w = pack2(st[mb][8 * sub + 6], st[mb][8 * sub + 7]);
        const bf16x8 pfrag = __builtin_bit_cast(bf16x8, pp);
#pragma unroll
        for (int eb = 0; eb < 4; ++eb) {
          const uint4 vv = *(const uint4*)(sV + eb * 32 * 144 + s4 * 32);
          ot[eb] = MFMA(__builtin_bit_cast(bf16x8, vv), pfrag, ot[eb]);
        }
      }
        __syncthreads();
      }
    }
    __builtin_amdgcn_s_setprio(0);
    const float ltot = l + shx(l, 32, tid);
    const float inv = 1.f / ltot;
#pragma unroll
    for (int eb = 0; eb < 4; ++eb)
#pragma unroll
      for (int q4 = 0; q4 < 4; ++q4) {
        uint2 o;
        o.x = pack2(ot[eb][4 * q4] * inv, ot[eb][4 * q4 + 1] * inv);
        o.y = pack2(ot[eb][4 * q4 + 2] * inv, ot[eb][4 * q4 + 3] * inv);
        *(uint2*)(smem + (wave * 32 + r) * 272 + (eb * 32 + 8 * q4 + 4 * hh) * 2) = o;
      }
    __syncthreads();
    {
      const int part = tid & 15, row0 = tid >> 4;
      const size_t tokb = (size_t)tokbase + qb * 256;
#pragma unroll 4
      for (int c = 0; c < 8; ++c) {
        const int row = row0 + c * 32;
        const uint4 ov = *(const uint4*)(smem + row * 272 + part * 16);
        const uint4 gg = *(const uint4*)(G + (tokb + row) * 2048 + h * 128 + part * 8);
        uint4 o;
        o.x = pack2(bflo(ov.x) * silu(bflo(gg.x)), bfhi(ov.x) * silu(bfhi(gg.x)));
        o.y = pack2(bflo(ov.y) * silu(bflo(gg.y)), bfhi(ov.y) * silu(bfhi(gg.y)));
        o.z = pack2(bflo(ov.z) * silu(bflo(gg.z)), bfhi(ov.z) * silu(bfhi(gg.z)));
        o.w = pack2(bflo(ov.w) * silu(bflo(gg.w)), bfhi(ov.w) * silu(bfhi(gg.w)));
        *(uint4*)(mixA + (tokb + row) * 1024 + h * 128 + part * 8) = o;
      }
    }
    __syncthreads();
  }
}

DI void phase_ret(const int wave_s, const Params& p, char* smem) {
  unsigned char* ws = launder_p(p.ws);
  const u16* RQ = (const u16*)(ws + WS_RQ);
  const u16* RK = (const u16*)(ws + WS_RK);
  const u16* RKt = (const u16*)(ws + WS_RKT);
  const u16* RVt = (const u16*)(ws + WS_RVT);
  const int tid = launder_v(launder_s(wave_s) * 64 + (int)__builtin_amdgcn_mbcnt_hi(launder_s(-1), __builtin_amdgcn_mbcnt_lo(-1, 0))), lane = tid & 63, wave = __builtin_amdgcn_readfirstlane(tid >> 6);
  const int r_ = lane & 31, hh_ = lane >> 5;
  constexpr int RS = 272;
  char* sQ = smem;
  char* sK = smem + 128 * RS;
  char* sKt = smem + 2 * 128 * RS;
  char* sVt = smem + 3 * 128 * RS;
  char* sSt = sVt + 64 * RS;
  float* sKd = (float*)(sSt + 64 * RS);
  float* sQd = sKd + 128;
  float* sDd = sQd + 128;
  float* sInv = sDd + 128;
  const int ib = wave >> 1, eb = wave & 1;
  for (int item = launder_s(blockIdx.x); item < 256 + 1024; item += gridDim.x) {
    int bb, hd, dir, dvs, L, tokbase;
    size_t rkt_off, rvt_off;
    bool sample;
    if (item < 256) {
      int it2 = item;
      if (gridDim.x == 256) { const int xcd = item & 7, i = item >> 3; it2 = ((xcd * 4 + (i >> 3)) << 3) | (i & 7); }
      sample = true; dvs = it2 & 3; dir = (it2 >> 2) & 1; hd = (it2 >> 3) & 3; bb = it2 >> 5; L = LS; tokbase = NTP + bb * LS;
      rkt_off = RKT_S_OFF + (size_t)(bb * 4 + hd) * 128 * LS; rvt_off = RVT_S_OFF + ((size_t)(bb * 4 + hd) * 256 + dvs * 64) * LS;
    } else {
      int it = item - 256;
      if (gridDim.x == 256) { const int xcd = it & 7, i = (it >> 3) & 31, j = it >> 8; it = ((j * 32 + xcd * 4 + (i >> 3)) << 3) | (i & 7); }
      sample = false; dvs = it & 3; dir = (it >> 2) & 1; hd = (it >> 3) & 3; bb = it >> 5; L = LP; tokbase = bb * LP;
      rkt_off = (size_t)(bb * 4 + hd) * 128 * LP; rvt_off = ((size_t)(bb * 4 + hd) * 256 + dvs * 64) * LP;
    }
    const float lg = -__expf(dir ? p.ld_bwd[hd] : p.ld_fwd[hd]);
    const float lg2 = lg * LOG2E;
    const float cdec = fexp2(128.f * lg2);
    if (tid < 128) {
      sKd[tid] = fexp2((float)(dir ? tid : 127 - tid) * lg2);
      sQd[tid] = fexp2((float)(dir ? 128 - tid : tid + 1) * lg2);
      sDd[tid] = fexp2((float)tid * lg2);
      if (tid < 32) sInv[tid] = fexp2(-(float)tid * lg2);
    }
    __syncthreads();
    u16* O = (u16*)(ws + (dir ? WS_OB : WS_OF));
    f32x16 S;
    {
    const int r = r_, hh = hh_;
    if (sample) {
      const float* s0 = (dir ? p.st_bwd : p.st_fwd) + (size_t)(bb * 4 + hd) * 128 * 256 + dvs * 64 + eb * 32 + r;
#pragma unroll
      for (int g = 0; g < 16; ++g) S[g] = s0[(size_t)(ib * 32 + crow(g, hh)) * 256];
    } else {
      zero16(S);
    }
    }
    const int n = L >> 7;
    const int row0_ = tid >> 4, part_ = tid & 15;
    uint4 pq0, pq1, pq2, pq3, pk0, pk1, pk2, pk3;
#define RET_LOADQK(c_)                                                               \
  {                                                                                   \
    const u16* bq = RQ + (size_t)(tokbase + (c_) * 128) * 512 + hd * 128;             \
    const u16* bk = RK + (size_t)(tokbase + (c_) * 128) * 512 + hd * 128;             \
    const unsigned o_ = (unsigned)(row0 * 512 + part * 8);                            \
    pq0 = *(const uint4*)(bq + o_); pq1 = *(const uint4*)(bq + o_ + 32 * 512);        \
    pq2 = *(const uint4*)(bq + o_ + 64 * 512); pq3 = *(const uint4*)(bq + o_ + 96 * 512); \
    pk0 = *(const uint4*)(bk + o_); pk1 = *(const uint4*)(bk + o_ + 32 * 512);        \
    pk2 = *(const uint4*)(bk + o_ + 64 * 512); pk3 = *(const uint4*)(bk + o_ + 96 * 512); \
  }
    { const int row0 = row0_, part = part_; RET_LOADQK(dir ? (n - 1) : 0); }
    for (int step = 0; step < n; ++step) {
      const int r = launder_v(r_), hh = launder_v(hh_), row0 = launder_v(row0_), part = launder_v(part_);
      const int c = dir ? (n - 1 - step) : step;
      const int tok0 = tokbase + c * 128;
#pragma unroll
      for (int q4 = 0; q4 < 4; ++q4) {
        uint2 o;
        o.x = pack2(S[4 * q4], S[4 * q4 + 1]); o.y = pack2(S[4 * q4 + 2], S[4 * q4 + 3]);
        *(uint2*)(sSt + (eb * 32 + r) * RS + (ib * 32 + 8 * q4 + 4 * hh) * 2) = o;
      }
      {
        char* dq = sQ + row0 * RS + part * 16;
        char* dk = sK + row0 * RS + part * 16;
        *(uint4*)(dq) = pq0; *(uint4*)(dq + 32 * RS) = pq1; *(uint4*)(dq + 64 * RS) = pq2; *(uint4*)(dq + 96 * RS) = pq3;
        *(uint4*)(dk) = pk0; *(uint4*)(dk + 32 * RS) = pk1; *(uint4*)(dk + 64 * RS) = pk2; *(uint4*)(dk + 96 * RS) = pk3;
      }
      const u16* bkt = RKt + rkt_off + c * 128;
      const u16* bvt = RVt + rvt_off + c * 128;
      const unsigned ot_ = (unsigned)(row0 * L + part * 8);
      uint4 kt0 = *(const uint4*)(bkt + ot_), kt1 = *(const uint4*)(bkt + ot_ + 32 * L);
      uint4 kt2 = *(const uint4*)(bkt + ot_ + 64 * L), kt3 = *(const uint4*)(bkt + ot_ + 96 * L);
      const uint4 vt0 = *(const uint4*)(bvt + ot_), vt1 = *(const uint4*)(bvt + ot_ + 32 * L);
      __syncthreads();
      f32x16 av[2];
#pragma unroll
      for (int jj = 0; jj < 2; ++jj) {
        const int jb = 2 * eb + jj;
        const bool skip = dir ? (jb < ib) : (jb > ib);
        if (skip) {
          zero16(av[jj]);
        } else {
          const char* ka = sK + (jb * 32 + r) * RS + hh * 16;
          const char* qa = sQ + (ib * 32 + r) * RS + hh * 16;
          const f32x16 zc = {0.f, 0.f, 0.f, 0.f, 0.f, 0.f, 0.f, 0.f, 0.f, 0.f, 0.f, 0.f, 0.f, 0.f, 0.f, 0.f};
          av[jj] = MFMA(*(const bf16x8*)(ka), *(const bf16x8*)(qa), zc);
#pragma unroll
          for (int s = 1; s < 8; ++s) av[jj] = MFMA(*(const bf16x8*)(ka + s * 32), *(const bf16x8*)(qa + s * 32), av[jj]);
          const int dblk = dir ? (jb - ib) : (ib - jb);
          const float lf = dir ? sInv[r] : sDd[dblk * 32 + r];
          const float* ct = dir ? (sDd + dblk * 32 + 4 * hh) : (sInv + 4 * hh);
#pragma unroll
          for (int q4 = 0; q4 < 4; ++q4) {
            const float4 c4 = *(const float4*)(ct + 8 * q4);
            av[jj][4 * q4 + 0] *= lf * c4.x;
            av[jj][4 * q4 + 1] *= lf * c4.y;
            av[jj][4 * q4 + 2] *= lf * c4.z;
            av[jj][4 * q4 + 3] *= lf * c4.w;
          }
          if (dblk == 0) {
#pragma unroll
            for (int g = 0; g < 16; ++g) {
              const int jl = crow(g, hh);
              const bool keep = dir ? (jl > r) : (jl <= r);
              av[jj][g] = keep ? av[jj][g] : 0.f;
            }
          }
        }
      }
      __syncthreads();
#pragma unroll
      for (int jj = 0; jj < 2; ++jj) {
        const int jb = 2 * eb + jj;
#pragma unroll
        for (int q4 = 0; q4 < 4; ++q4) {
          uint2 o;
          o.x = pack2(av[jj][4 * q4], av[jj][4 * q4 + 1]); o.y = pack2(av[jj][4 * q4 + 2], av[jj][4 * q4 + 3]);
          *(uint2*)(sK + (ib * 32 + r) * RS + (jb * 32 + 8 * q4 + 4 * hh) * 2) = o;
        }
      }
      {
        const float4 d0 = *(const float4*)(sKd + part * 8), d1 = *(const float4*)(sKd + part * 8 + 4);
#define RET_SCALE(kt)                                                                   \
  kt.x = pack2(bflo(kt.x) * d0.x, bfhi(kt.x) * d0.y); kt.y = pack2(bflo(kt.y) * d0.z, bfhi(kt.y) * d0.w); \
  kt.z = pack2(bflo(kt.z) * d1.x, bfhi(kt.z) * d1.y); kt.w = pack2(bflo(kt.w) * d1.z, bfhi(kt.w) * d1.w);
        RET_SCALE(kt0) RET_SCALE(kt1) RET_SCALE(kt2) RET_SCALE(kt3)
        char* dkt = sKt + row0 * RS + part * 16;
        *(uint4*)(dkt) = kt0; *(uint4*)(dkt + 32 * RS) = kt1; *(uint4*)(dkt + 64 * RS) = kt2; *(uint4*)(dkt + 96 * RS) = kt3;
        char* dvt = sVt + row0 * RS + part * 16;
        *(uint4*)(dvt) = vt0; *(uint4*)(dvt + 32 * RS) = vt1;
      }
      if (step + 1 < n) RET_LOADQK(dir ? (n - 2 - step) : (step + 1));
      __syncthreads();
      {
        f32x16 a1, a2;
        zero16(a1);
        const char* aa = sK + (ib * 32 + r) * RS + hh * 16;
        const char* va = sVt + (eb * 32 + r) * RS + hh * 16;
        const char* qa = sQ + (ib * 32 + r) * RS + hh * 16;
        const char* sa = sSt + (eb * 32 + r) * RS + hh * 16;
        const int slo = dir ? 2 * ib : 0, shi = dir ? 8 : 2 * ib + 2;
#pragma unroll
        for (int s = 0; s < 8; ++s)
          if (s >= slo && s < shi) a1 = MFMA(*(const bf16x8*)(aa + s * 32), *(const bf16x8*)(va + s * 32), a1);
        {
          const f32x16 zc = {0.f, 0.f, 0.f, 0.f, 0.f, 0.f, 0.f, 0.f, 0.f, 0.f, 0.f, 0.f, 0.f, 0.f, 0.f, 0.f};
          a2 = MFMA(*(const bf16x8*)(qa), *(const bf16x8*)(sa), zc);
        }
#pragma unroll
        for (int s = 1; s < 8; ++s) a2 = MFMA(*(const bf16x8*)(qa + s * 32), *(const bf16x8*)(sa + s * 32), a2);
        u16* od = O + (size_t)tok0 * 1024 + hd * 256 + dvs * 64;
        const int r2 = launder_v(r), hh2 = launder_v(hh);
#pragma unroll
        for (int q4 = 0; q4 < 4; ++q4) {
          const int i0 = ib * 32 + 8 * q4 + 4 * hh2;
          const float4 qd = *(const float4*)(sQd + i0);
          const unsigned o0 = (unsigned)(i0 * 1024 + eb * 32 + r2);
          od[o0] = f2bf(a1[4 * q4 + 0] + qd.x * a2[4 * q4 + 0]);
          od[o0 + 1024] = f2bf(a1[4 * q4 + 1] + qd.y * a2[4 * q4 + 1]);
          od[o0 + 2048] = f2bf(a1[4 * q4 + 2] + qd.z * a2[4 * q4 + 2]);
          od[o0 + 3072] = f2bf(a1[4 * q4 + 3] + qd.w * a2[4 * q4 + 3]);
        }
      }
      {
#pragma unroll
        for (int g = 0; g < 16; ++g) S[g] *= cdec;
        const char* ka = sKt + (ib * 32 + r) * RS + hh * 16;
        const char* va = sVt + (eb * 32 + r) * RS + hh * 16;
#pragma unroll
        for (int s = 0; s < 8; ++s) S = MFMA(*(const bf16x8*)(ka + s * 32), *(const bf16x8*)(va + s * 32), S);
      }
      __syncthreads();
    }
    if (!sample) {
      const int r = r_, hh = hh_;
      float* sd = p.out + (dir ? OUT_SB : OUT_SF) + (size_t)(bb * 4 + hd) * 128 * 256 + dvs * 64 + eb * 32 + r;
#pragma unroll
      for (int g = 0; g < 16; ++g) sd[(size_t)(ib * 32 + crow(g, hh)) * 256] = S[g];
    }
  }
}

DI void phase6(const int wave_s, const Params& p) {
  unsigned char* ws = launder_p(p.ws);
  const u16* OF = (const u16*)(ws + WS_OF);
  u16* MR = (u16*)(ws + WS_MIXR);
  const u16* OB = (const u16*)(ws + WS_OB);
  const u16* G = (const u16*)(ws + WS_G);
  const int tid = launder_v(launder_s(wave_s) * 64 + (int)__builtin_amdgcn_mbcnt_hi(launder_s(-1), __builtin_amdgcn_mbcnt_lo(-1, 0)));
  const int lane = tid & 63, wave = tid >> 6;
  for (int it = launder_s(blockIdx.x) * 8 + wave; it < NT * 4; it += gridDim.x * 8) {
    const int tok = it >> 2, hd = it & 3;
    const size_t off = (size_t)tok * 1024 + hd * 256 + lane * 4;
    const uint2 a = *(const uint2*)(OF + off);
    const uint2 b = *(const uint2*)(OB + off);
    const uint2 g = *(const uint2*)(G + (size_t)tok * 2048 + 1024 + hd * 256 + lane * 4);
    const float4 w = *(const float4*)(p.gn_w + hd * 256 + lane * 4);
    const float v0 = bflo(a.x) + bflo(b.x), v1 = bfhi(a.x) + bfhi(b.x), v2 = bflo(a.y) + bflo(b.y), v3 = bfhi(a.y) + bfhi(b.y);
    float ss = v0 * v0 + v1 * v1 + v2 * v2 + v3 * v3;
#pragma unroll
    for (int o = 32; o >= 1; o >>= 1) ss += shx(ss, o, tid);
    const float rinv = rsqrtf(ss * (1.f / 256.f) + EPSF);
    uint2 o;
    o.x = pack2(v0 * rinv * w.x * silu(bflo(g.x)), v1 * rinv * w.y * silu(bfhi(g.x)));
    o.y = pack2(v2 * rinv * w.z * silu(bflo(g.y)), v3 * rinv * w.w * silu(bfhi(g.y)));
    *(uint2*)(MR + off) = o;
  }
}

DI void phase7(const int wave_s, const Params& p, char* smem) {
  unsigned char* ws = launder_p(p.ws);
  const u16* mixA = (const u16*)(ws + WS_MIXA);
  const u16* mixR = (const u16*)(ws + WS_MIXR);
  const u16* WoT = (const u16*)(ws + WS_WOT);
  const float* mod = (const float*)(ws + WS_MOD);
  const int tid = launder_v(launder_s(wave_s) * 64 + (int)__builtin_amdgcn_mbcnt_hi(launder_s(-1), __builtin_amdgcn_mbcnt_lo(-1, 0)));
  const int lane = tid & 63, wave = tid >> 6;
  const int r = lane & 31, hh = lane >> 5;
  const int xcd = launder_s(blockIdx.x) & 7, bi = launder_s(blockIdx.x) >> 3, nb = gridDim.x >> 3;
  if (bi >= nb) return;
  for (int pos = xcd * 160 + bi; pos < (xcd + 1) * 160; pos += nb) {
    const int patch = pos >> 5, i = pos & 31;
    const int mt = (patch >> 1) * 8 + (i & 7), nt = (patch & 1) * 4 + (i >> 3);
    const int tok0 = mt * 256, n0 = nt * 256;
    f32x4 acc[2][2][4][2];
    gemm8p(acc, WoT + (size_t)n0 * D, D, mixA + (size_t)tok0 * 1024, mixR + (size_t)tok0 * 1024, 1024, 1024, 32, smem, tid);
    const int wr = wave >> 2, wc = wave & 3, fr = lane & 15, fq = lane >> 4;
    const int mrow = (tok0 < NTP) ? 8 : ((tok0 - NTP) >> 12);
    const float* gate = mod + mrow * 6144 + 4096 + n0 + wr * 64 + fq * 4;
#pragma unroll
    for (int a = 0; a < 2; ++a)
#pragma unroll
      for (int m = 0; m < 4; ++m) {
        const f32x4 g4 = *(const f32x4*)(gate + a * 128 + m * 16);
#pragma unroll
        for (int b = 0; b < 2; ++b)
#pragma unroll
          for (int n = 0; n < 2; ++n) {
            const f32x4 v = acc[a][b][m][n] * g4;
            uint2 o;
            o.x = pack2(v[0], v[1]); o.y = pack2(v[2], v[3]);
            *(uint2*)(smem + (b * 128 + wc * 32 + n * 16 + fr) * 528 + (a * 128 + wr * 64 + m * 16 + fq * 4) * 2) = o;
          }
      }
    __syncthreads();
    {
      const int part = tid & 31, row0 = tid >> 5;
      const float* xb = ((tok0 < NTP) ? (p.x_prompt + (size_t)tok0 * D) : (p.x_sample + (size_t)(tok0 - NTP) * D)) + n0 + part * 8;
      float* ob = p.out + OUT_YP + (size_t)tok0 * D + n0 + part * 8;
#pragma unroll 4
      for (int c = 0; c < 16; ++c) {
        const int row = row0 + c * 16;
        const uint4 dv = *(const uint4*)(smem + row * 528 + part * 16);
        const float4 x0 = *(const float4*)(xb + (size_t)row * D), x1 = *(const float4*)(xb + (size_t)row * D + 4);
        float4 o0, o1;
        o0.x = x0.x + bflo(dv.x); o0.y = x0.y + bfhi(dv.x); o0.z = x0.z + bflo(dv.y); o0.w = x0.w + bfhi(dv.y);
        o1.x = x1.x + bflo(dv.z); o1.y = x1.y + bfhi(dv.z); o1.z = x1.z + bflo(dv.w); o1.w = x1.w + bfhi(dv.w);
        *(float4*)(ob + (size_t)row * D) = o0;
        *(float4*)(ob + (size_t)row * D + 4) = o1;
      }
    }
    __syncthreads();
  }
}

#ifndef PROBE_REP_P0
#define PROBE_REP_P0 0
#endif
#ifndef PROBE_REP_P1
#define PROBE_REP_P1 0
#endif
#ifndef PROBE_REP_P3
#define PROBE_REP_P3 0
#endif
#ifndef PROBE_REP_P6
#define PROBE_REP_P6 0
#endif
#ifndef PROBE_REP_ATTN
#define PROBE_REP_ATTN 0
#endif
#ifndef PROBE_REP_RET
#define PROBE_REP_RET 0
#endif
#ifndef PROBE_REP_G1
#define PROBE_REP_G1 0
#endif
#ifndef PROBE_REP_G2
#define PROBE_REP_G2 0
#endif
#define XB_TMO 128
#define XB_XCNT(j) (256 + 64 * (j))
#define XB_XSUB(j) (1280 + 64 * (j))
#define XB_XGEN(j) (2304 + 64 * (j))
#define XB_TOP 3328
#define XB_TOPGEN 3392
#define XB_SPIN_CAP (1u << 22)
DI unsigned xb_ld(unsigned* q) { return __hip_atomic_load(q, __ATOMIC_RELAXED, __HIP_MEMORY_SCOPE_AGENT); }
DI unsigned xb_add(unsigned* q, unsigned v) { return __hip_atomic_fetch_add(q, v, __ATOMIC_RELAXED, __HIP_MEMORY_SCOPE_AGENT); }
DI unsigned xb_xcc_id() { return (unsigned)__builtin_amdgcn_s_getreg((3 << 11) | 20) & 0xFu; }
#define XB_SPIN(cond, bar)                                                                  \
  do {                                                                                       \
    unsigned _sp = 0;                                                                        \
    while (cond) {                                                                           \
      __builtin_amdgcn_s_sleep(1);                                                           \
      if ((++_sp & 255u) == 0u) {                                                            \
        if (xb_ld(&(bar)[XB_TMO])) break;                                                    \
        if (_sp > XB_SPIN_CAP) { atomicAdd(&(bar)[XB_TMO], 1u); break; }                     \
      }                                                                                      \
    }                                                                                        \
  } while (0)
DI void xb_complete(unsigned* bar, unsigned x, unsigned G, unsigned& nloc, unsigned& nx) {
  unsigned sum, cnt, mine, sp = 0u;
  for (;;) {
    sum = 0u; cnt = 0u; mine = 0u;
#pragma unroll
    for (unsigned j = 0; j < 16; ++j) { const unsigned c = xb_ld(&bar[XB_XCNT(j)]); sum += c; cnt += (c > 0u) ? 1u : 0u; mine = (j == x) ? c : mine; }
    if (sum == G) break;
    __builtin_amdgcn_s_sleep(1);
    if ((++sp & 255u) == 0u) { if (xb_ld(&bar[XB_TMO])) break; if (sp > XB_SPIN_CAP) { atomicAdd(&bar[XB_TMO], 1u); break; } }
  }
  nloc = mine > 0u ? mine : 1u; nx = cnt > 0u ? cnt : 1u;
}
DI void xcd_barrier(unsigned* bar, const unsigned x, volatile LAS unsigned* st, const bool t0) {
  asm volatile("s_waitcnt vmcnt(0)" ::: "memory");
  __syncthreads();
  if (t0) {
    __builtin_amdgcn_s_waitcnt(0);
    unsigned nloc = st[0], nx = st[1];
    if (nloc == 0u) { xb_complete(bar, x, gridDim.x, nloc, nx); st[0] = nloc; st[1] = nx; }
    const unsigned old = xb_add(&bar[XB_XSUB(x)], 1u);
    const unsigned gen = old / nloc;
    if (old + 1u == (gen + 1u) * nloc) {
      __builtin_amdgcn_fence(__ATOMIC_RELEASE, "agent");
      asm volatile("s_waitcnt vmcnt(0)" ::: "memory");
      const unsigned og = xb_add(&bar[XB_TOP], 1u);
      const unsigned tg = og / nx;
      if (og + 1u == (tg + 1u) * nx) xb_add(&bar[XB_TOPGEN], 1u);
      else XB_SPIN(xb_ld(&bar[XB_TOPGEN]) == tg, bar);
      __builtin_amdgcn_fence(__ATOMIC_ACQUIRE, "agent");
      xb_add(&bar[XB_XGEN(x)], 1u);
      asm volatile("s_waitcnt vmcnt(0)" ::: "memory");
    } else {
      XB_SPIN(xb_ld(&bar[XB_XGEN(x)]) == gen, bar);
      __builtin_amdgcn_fence(__ATOMIC_ACQUIRE, "agent");
      asm volatile("s_waitcnt vmcnt(0)" ::: "memory");
    }
  }
  __syncthreads();
}

__global__ void __launch_bounds__(512) fwd_megakernel(Params p) {
  extern __shared__ __attribute__((aligned(16))) char smem[];
  cg::grid_group grid = cg::this_grid();
  const int wave_s = __builtin_amdgcn_readfirstlane((int)(threadIdx.x >> 6));
  unsigned* xbar = (unsigned*)(p.ws + WS_BAR);
  volatile LAS unsigned* xst = (volatile LAS unsigned*)((LAS char*)smem + (LDS_BYTES - 16));
  const unsigned xcc = xb_xcc_id();
  if (threadIdx.x == 0) { xst[0] = 0u; xst[1] = 0u; xst[2] = 0u; xst[3] = 0u; (void)xb_add(&xbar[XB_XCNT(xcc)], 1u); }
  __syncthreads();
  const bool multi = (p.phase_hi - p.phase_lo) > 1;
  for (int ph = p.phase_lo; ph < p.phase_hi; ++ph) {
    if (ph == 0) { phase0(wave_s, p, smem, false); if (PROBE_REP_P0) { __syncthreads(); phase0(wave_s, p, smem, true); } }
    else if (ph == 1) { phase1(wave_s, p); if (PROBE_REP_P1) { __syncthreads(); phase1(wave_s, p); } }
    else if (ph == 2) { phase2(wave_s, p, smem); if (PROBE_REP_G1) { __syncthreads(); phase2(wave_s, p, smem); } }
    else if (ph == 3) { phase3(wave_s, p, smem); if (PROBE_REP_P3) { __syncthreads(); phase3(wave_s, p, smem); } }
    else if (ph == 4) { phase_attn(wave_s, p, smem); if (PROBE_REP_ATTN) { __syncthreads(); phase_attn(wave_s, p, smem); } phase_ret(wave_s, p, smem); if (PROBE_REP_RET) { __syncthreads(); phase_ret(wave_s, p, smem); } }
    else if (ph == 5) { phase6(wave_s, p); if (PROBE_REP_P6) { __syncthreads(); phase6(wave_s, p); } }
    else { phase7(wave_s, p, smem); if (PROBE_REP_G2) { __syncthreads(); phase7(wave_s, p, smem); } }
    if (multi && ph + 1 < p.phase_hi) {
      if (p.phase_hi > 64) grid.sync();
      xcd_barrier(xbar, xcc, xst, wave_s == 0 && __builtin_amdgcn_mbcnt_hi(-1, __builtin_amdgcn_mbcnt_lo(-1, 0)) == 0);
    }
  }
}

#ifndef N_LAUNCH_MODE
#define N_LAUNCH_MODE 1
#endif

extern "C" void kernel_launch(void* const* d_in, const int* in_sizes, int n_in, void* d_out, int out_size, void* d_ws, size_t ws_size,
                              hipStream_t stream) {
  static int grid_blocks = 0;
  if (grid_blocks == 0) {
    if (n_in != 23 || ws_size < WS_END) {
      fprintf(stderr, "kernel_launch: need 23 inputs and >= %zu bytes of workspace; got %d, %zu\n", (size_t)WS_END, n_in, ws_size);
      grid_blocks = -1;
      return;
    }
    int dev = 0, cus = 0, per_cu = 0;
    hipGetDevice(&dev);
    hipDeviceGetAttribute(&cus, hipDeviceAttributeMultiprocessorCount, dev);
    hipFuncSetAttribute((const void*)fwd_megakernel, hipFuncAttributeMaxDynamicSharedMemorySize, LDS_BYTES);
    hipOccupancyMaxActiveBlocksPerMultiprocessor(&per_cu, (const void*)fwd_megakernel, 512, LDS_BYTES);
    if (per_cu < 1) { fprintf(stderr, "kernel_launch: occupancy query says %d blocks/CU\n", per_cu); per_cu = 1; }
    grid_blocks = cus;
    grid_blocks &= ~7;
    (void)hipGetLastError();
  }
  if (grid_blocks < 0) return;
  Params p{};
  p.x_prompt = (const float*)d_in[0]; p.x_sample = (const float*)d_in[1]; p.c = (const float*)d_in[2];
  p.cache_ckv = (const float*)d_in[3]; p.cache_krope = (const float*)d_in[4]; p.st_fwd = (const float*)d_in[5];
  p.st_bwd = (const float*)d_in[6]; p.c_ctx = (const float*)d_in[7]; p.norm_w = (const float*)d_in[8];
  p.w_mod = (const float*)d_in[9]; p.b_mod = (const float*)d_in[10]; p.w_in = (const float*)d_in[11];
  p.q_norm_w = (const float*)d_in[12]; p.w_uq = (const float*)d_in[13]; p.kv_norm_w = (const float*)d_in[14];
  p.w_uk = (const float*)d_in[15]; p.w_uv = (const float*)d_in[16]; p.qk_q_w = (const float*)d_in[17];
  p.qk_k_w = (const float*)d_in[18]; p.ld_fwd = (const float*)d_in[19]; p.ld_bwd = (const float*)d_in[20];
  p.gn_w = (const float*)d_in[21]; p.w_out = (const float*)d_in[22];
  p.out = (float*)d_out; p.ws = (unsigned char*)d_ws;
  hipMemsetAsync((char*)d_ws + WS_MOD, 0, WS_ROPE2D - WS_MOD, stream);
#if N_LAUNCH_MODE == 1
  p.phase_lo = 0; p.phase_hi = 7;
  void* args[] = {&p};
  hipError_t e = hipLaunchCooperativeKernel((const void*)fwd_megakernel, dim3(grid_blocks), dim3(512), args, LDS_BYTES, stream);
  if (e != hipSuccess) fprintf(stderr, "cooperative launch failed: %s (grid %d)\n", hipGetErrorString(e), grid_blocks);
#else
  for (int ph = 0; ph < 7; ++ph) {
    p.phase_lo = ph; p.phase_hi = ph + 1;
    hipLaunchKernelGGL(fwd_megakernel, dim3(grid_blocks), dim3(512), LDS_BYTES, stream, p);
  }
#endif
}
```

```cpp
#include <hip/hip_runtime.h>
#include <hip/hip_cooperative_groups.h>
#include <cstdio>
#include <cstdint>
namespace cg = cooperative_groups;

typedef __attribute__((ext_vector_type(8))) short bf16x8;
typedef __attribute__((ext_vector_type(16))) float f32x16;
typedef __attribute__((ext_vector_type(2))) __bf16 bf2_t;
typedef unsigned short u16;
#define DI __device__ __forceinline__
#define MFMA(a, b, c) __builtin_amdgcn_mfma_f32_32x32x16_bf16((a), (b), (c), 0, 0, 0)

constexpr int D = 2048;
constexpr int NTP = 8192;
constexpr int NTS = 32768;
constexpr int NT = NTP + NTS;
constexpr int LP = 256, LS = 4096, NKS = 4352;
constexpr int PSW = 704;
constexpr float EPSF = 1e-6f;
constexpr float LOG2E = 1.4426950408889634f;

constexpr size_t al256(size_t x) { return (x + 255) & ~(size_t)255; }
constexpr size_t WS_MOD = 0;
constexpr size_t WS_BAR = al256(WS_MOD + 9 * 6144 * 4);
constexpr size_t WS_ROPE2D = al256(WS_BAR + 3456 * 4);
constexpr size_t WS_ROPER = al256(WS_ROPE2D + 64 * 16 * 8);
constexpr size_t WS_WIT = al256(WS_ROPER + (size_t)4096 * 64 * 8);
constexpr size_t WS_WUQT = al256(WS_WIT + (size_t)4864 * 2048 * 2);
constexpr size_t WS_WUKT = al256(WS_WUQT + (size_t)1536 * 384 * 2);
constexpr size_t WS_WUVT = al256(WS_WUKT + (size_t)1024 * 256 * 2);
constexpr size_t WS_WOT = al256(WS_WUVT + (size_t)1024 * 256 * 2);
constexpr size_t WS_CK = al256(WS_WOT + (size_t)2048 * 2048 * 2);
constexpr size_t WS_QF = al256(WS_CK + (size_t)2048 * 256 * 2);
constexpr size_t WS_G = al256(WS_QF + (size_t)NT * 8 * 4);
constexpr size_t WS_RQ = al256(WS_G + (size_t)NT * 2048 * 2);
constexpr size_t WS_RK = al256(WS_RQ + (size_t)NT * 512 * 2);
constexpr size_t WS_RKT = al256(WS_RK + (size_t)NT * 512 * 2);
constexpr size_t WS_RVT = al256(WS_RKT + (size_t)NT * 512 * 2);
constexpr size_t WS_REGD = al256(WS_RVT + (size_t)NT * 1024 * 2);
constexpr size_t WS_H = WS_REGD;
constexpr size_t WS_Q = WS_REGD;
constexpr size_t WS_K = al256(WS_Q + (size_t)NT * 8 * 192 * 2);
constexpr size_t K_ELEMS = (size_t)NTP * 8 * 192 + (size_t)8 * 8 * NKS * 192;
constexpr size_t WS_VT = al256(WS_K + K_ELEMS * 2);
constexpr size_t VT_ELEMS = (size_t)NTP * 8 * 128 + (size_t)8 * 8 * 128 * NKS;
constexpr size_t WS_REGE = al256(WS_VT + VT_ELEMS * 2);
constexpr size_t WS_PS = WS_REGE;
constexpr size_t WS_OF = WS_REGE;
constexpr size_t WS_OB = al256(WS_OF + (size_t)NT * 1024 * 2);
constexpr size_t WS_MIXA = al256(WS_OB + (size_t)NT * 1024 * 2);
constexpr size_t WS_MIXR = WS_REGD;
constexpr size_t WS_END = al256(WS_MIXA + (size_t)NT * 1024 * 2);

constexpr size_t Q_S_OFF = (size_t)NTP * 8 * 192;
constexpr size_t K_S_OFF = (size_t)NTP * 8 * 192;
constexpr size_t VT_S_OFF = (size_t)NTP * 8 * 128;
constexpr size_t RKT_S_OFF = (size_t)NTP * 512;
constexpr size_t RVT_S_OFF = (size_t)NTP * 1024;

constexpr size_t OUT_YP = 0;
constexpr size_t OUT_CKV = (size_t)NT * 2048;
constexpr size_t OUT_KROPE = OUT_CKV + (size_t)NTP * 256;
constexpr size_t OUT_SF = OUT_KROPE + (size_t)NTP * 64;
constexpr size_t OUT_SB = OUT_SF + (size_t)32 * 4 * 128 * 256;

constexpr int LDS_BYTES = 147456;

struct Params {
  const float* x_prompt; const float* x_sample; const float* c; const float* cache_ckv; const float* cache_krope;
  const float* st_fwd; const float* st_bwd; const float* c_ctx; const float* norm_w; const float* w_mod; const float* b_mod;
  const float* w_in; const float* q_norm_w; const float* w_uq; const float* kv_norm_w; const float* w_uk; const float* w_uv;
  const float* qk_q_w; const float* qk_k_w; const float* ld_fwd; const float* ld_bwd; const float* gn_w; const float* w_out;
  float* out; unsigned char* ws;
  int phase_lo, phase_hi;
};

DI unsigned pack2(float a, float b) { bf2_t v; v[0] = (__bf16)a; v[1] = (__bf16)b; return __builtin_bit_cast(unsigned, v); }
DI u16 f2bf(float a) { __bf16 v = (__bf16)a; return __builtin_bit_cast(u16, v); }
DI float bf2f(u16 u) { return __uint_as_float(((unsigned)u) << 16); }
DI float bflo(unsigned u) { return __uint_as_float(u << 16); }
DI float bfhi(unsigned u) { return __uint_as_float(u & 0xffff0000u); }
DI int crow(int reg, int hh) { return (reg & 3) + 8 * (reg >> 2) + 4 * hh; }
DI int launder_v(int x) { asm volatile("" : "+v"(x)); return x; }
DI int launder_s(int x) { asm volatile("" : "+s"(x)); return x; }
DI unsigned char* launder_p(unsigned char* x) { return x + (size_t)(unsigned)launder_s(0); }
DI float shx(float x, int k, int tid) { return __int_as_float(__builtin_amdgcn_ds_bpermute(((tid ^ k) & 63) << 2, __float_as_int(x))); }
DI float fexp2(float x) { return __builtin_amdgcn_exp2f(x); }
DI float silu(float x) { return x / (1.f + __expf(-x)); }
DI void zero16(f32x16& a) {
#pragma unroll
  for (int i = 0; i < 16; ++i) a[i] = 0.f;
}
DI void sincos_acc(double a, float& s, float& c) {
  double q = rint(a * 0.63661977236758134308);
  double r = a - q * 1.57079632679489661923;
  r = r - q * 6.123233995736766e-17;
  int qi = ((int)q) & 3;
  double r2 = r * r;
  double sn = r * (1.0 - r2 / 6.0 * (1.0 - r2 / 20.0 * (1.0 - r2 / 42.0 * (1.0 - r2 / 72.0 * (1.0 - r2 / 110.0 * (1.0 - r2 / 156.0))))));
  double cs = 1.0 - r2 / 2.0 * (1.0 - r2 / 12.0 * (1.0 - r2 / 30.0 * (1.0 - r2 / 56.0 * (1.0 - r2 / 90.0 * (1.0 - r2 / 132.0 * (1.0 - r2 / 182.0))))));
  double so, co;
  if (qi == 0) { so = sn; co = cs; } else if (qi == 1) { so = cs; co = -sn; } else if (qi == 2) { so = -sn; co = -cs; } else { so = -cs; co = sn; }
  s = (float)so; c = (float)co;
}

template <int RB, int LB, int WR, int WL>
DI void gemm_tile(f32x16 (&acc)[RB][LB], const u16* __restrict__ Rp, const u16* __restrict__ Rp2, int ksplit, int ldr,
                  const u16* __restrict__ Lp, int ldl, int K, char* smem, const int tid) {
  constexpr int NR = RB * WR * 32, NL = LB * WL * 32;
  constexpr int NCH = (NR + NL) / 64;
  constexpr int NCR = NR / 64;
  constexpr int STAGE = (NR + NL) * 144;
  static_assert(WR * WL == 8, "8 waves");
  static_assert(2 * STAGE <= LDS_BYTES, "lds");
  const int lane = tid & 63, wave = tid >> 6;
  const int wr = wave / WL, wl = wave % WL;
  const int r = lane & 31, hh = lane >> 5;
  const int lrow = tid >> 3, kc = tid & 7;
#pragma unroll
  for (int i = 0; i < RB; ++i)
#pragma unroll
    for (int j = 0; j < LB; ++j) zero16(acc[i][j]);
  uint4 pf0, pf1, pf2, pf3, pf4, pf5, pf6, pf7;
  static_assert(NCH <= 8, "NCH");
  const unsigned roff = (unsigned)lrow * (unsigned)ldr + kc * 8;
  const unsigned loff = (unsigned)lrow * (unsigned)ldl + kc * 8;
  char* const swbase = smem + lrow * 144 + kc * 16;
#define GT_GL1(c)                                                                                                   \
  if constexpr ((c) < NCH) {                                                                                        \
    if constexpr ((c) < NCR) pf##c = *(const uint4*)(rb_ + (roff + (unsigned)((c) * 64) * (unsigned)ldr));          \
    else pf##c = *(const uint4*)(lb_ + (loff + (unsigned)(((c) - NCR) * 64) * (unsigned)ldl));                      \
  }
#define GT_GLOAD(k0_)                                                                     \
  {                                                                                       \
    const int k0 = (k0_);                                                                 \
    const u16* rb_ = (k0 < ksplit) ? (Rp + k0) : (Rp2 + (k0 - ksplit));                   \
    const u16* lb_ = Lp + k0;                                                             \
    GT_GL1(0) GT_GL1(1) GT_GL1(2) GT_GL1(3) GT_GL1(4) GT_GL1(5) GT_GL1(6) GT_GL1(7)       \
  }
#define GT_SW1(c) if constexpr ((c) < NCH) *(uint4*)(sb_ + (c) * 64 * 144) = pf##c;
#define GT_SWRITE(st_)                                                                    \
  {                                                                                       \
    char* sb_ = swbase + (st_) * STAGE;                                                   \
    GT_SW1(0) GT_SW1(1) GT_SW1(2) GT_SW1(3) GT_SW1(4) GT_SW1(5) GT_SW1(6) GT_SW1(7)       \
  }
  int nk = K >> 6;
  asm volatile("" : "+s"(nk));
  GT_GLOAD(0);
  for (int kt = 0; kt < nk; ++kt) {
    GT_SWRITE(kt & 1);
    __syncthreads();
    const int ktn = (kt + 1 < nk) ? (kt + 1) : kt;
    GT_GLOAD(ktn << 6);
    const char* sR = smem + (kt & 1) * STAGE + (wr * RB * 32 + r) * 144 + hh * 16;
    const char* sL = smem + (kt & 1) * STAGE + (NR + wl * LB * 32 + r) * 144 + hh * 16;
#pragma unroll
    for (int s = 0; s < 4; ++s) {
      bf16x8 rf[RB], lf[LB];
#pragma unroll
      for (int i = 0; i < RB; ++i) rf[i] = *(const bf16x8*)(sR + i * 32 * 144 + s * 32);
#pragma unroll
      for (int j = 0; j < LB; ++j) lf[j] = *(const bf16x8*)(sL + j * 32 * 144 + s * 32);
#pragma unroll
      for (int i = 0; i < RB; ++i)
#pragma unroll
        for (int j = 0; j < LB; ++j) acc[i][j] = MFMA(rf[i], lf[j], acc[i][j]);
    }
  }
  __syncthreads();
}

typedef __attribute__((ext_vector_type(4))) float f32x4;
#define LAS __attribute__((address_space(3)))
DI int g8_lds_byte(int r, int c) {
  const int st = (r >> 4) * 2 + (c >> 5), rr = r & 15, cc = c & 31, ob = rr * 64 + cc * 2;
  return st * 1024 + (ob ^ (((ob >> 9) & 1) << 5));
}
DI void g8_stage_rc(int b, int& R, int& C) {
  const int st = b / 1024, sb = b % 1024, swz = sb ^ (((sb >> 9) & 1) << 5);
  R = (st >> 1) * 16 + swz / 64;
  C = (st & 1) * 32 + (swz % 64) / 2;
}
DI void gemm8p(f32x4 (&acc)[2][2][4][2], const u16* __restrict__ Ap, int lda, const u16* __restrict__ Bp, const u16* __restrict__ Bp2, int ksplit,
               int ldb, int nt_, char* smem, const int tid) {
  constexpr int HTB = 16384;
  const int nt = launder_s(nt_);
  LAS char* lds = (LAS char*)smem;
  const int wid = __builtin_amdgcn_readfirstlane(tid >> 6), lane = tid & 63, wr = wid >> 2, wc = wid & 3, fr = lane & 15, fq = lane >> 4;
  unsigned voffA[2], voffB[2];
#pragma unroll
  for (int i = 0; i < 2; ++i) {
    int R, C;
    g8_stage_rc(tid * 16 + i * 8192, R, C);
    voffA[i] = (unsigned)launder_v((R * lda + C) * 2);
    voffB[i] = (unsigned)launder_v((R * ldb + C) * 2);
  }
  const size_t hA = (size_t)128 * lda * 2, hB = (size_t)128 * ldb * 2;
  const unsigned ldsw = (unsigned)wid * 1024u;
  const int aoff = g8_lds_byte(wr * 64 + fr, fq * 8), boff = g8_lds_byte(wc * 32 + fr, fq * 8);
  const char* cA = (const char*)Ap;
#define G8_SA(b, h) (((b) * 2 + (h)) * HTB)
#define G8_SB(b, h) ((4 + (b) * 2 + (h)) * HTB)
#define G8_BK(kt) ((const char*)(((kt) * 64 < ksplit) ? (Bp + (kt) * 64) : (Bp2 + ((kt) * 64 - ksplit))))
#define G8_AK(kt) (cA + (size_t)(kt) * 128)
#define G8_STAGE(bufoff, gbase, voff)                                                                                         \
  do {                                                                                                                        \
    _Pragma("unroll") for (int _i = 0; _i < 2; ++_i) __builtin_amdgcn_global_load_lds(                                        \
        (const unsigned*)((const char*)(gbase) + (voff)[_i]), (LAS unsigned*)(lds + (bufoff) + ldsw + _i * 8192), 16, 0, 0);  \
  } while (0)
#define G8_LDA(dst, b, h)                                                                               \
  do {                                                                                                  \
    _Pragma("unroll") for (int m = 0; m < 4; ++m) _Pragma("unroll") for (int k = 0; k < 2; ++k)         \
        dst[m][k] = *(const LAS bf16x8*)(lds + G8_SA(b, h) + aoff + m * 2048 + k * 1024);               \
  } while (0)
#define G8_LDB(dst, b, h)                                                                               \
  do {                                                                                                  \
    _Pragma("unroll") for (int n = 0; n < 2; ++n) _Pragma("unroll") for (int k = 0; k < 2; ++k)         \
        dst[n][k] = *(const LAS bf16x8*)(lds + G8_SB(b, h) + boff + n * 2048 + k * 1024);               \
  } while (0)
#define G8_MMA(ai, bj, At_, Bt_)                                                                                              \
  do {                                                                                                                        \
    __builtin_amdgcn_s_setprio(1);                                                                                            \
    _Pragma("unroll") for (int m = 0; m < 4; ++m) _Pragma("unroll") for (int n = 0; n < 2; ++n) _Pragma("unroll") for (int k = 0; k < 2; ++k) \
        acc[ai][bj][m][n] = __builtin_amdgcn_mfma_f32_16x16x32_bf16(At_[m][k], Bt_[n][k], acc[ai][bj][m][n], 0, 0, 0);       \
    __builtin_amdgcn_s_setprio(0);                                                                                            \
  } while (0)
#define G8_WAIT_V(n) asm volatile("s_waitcnt vmcnt(" #n ")" ::: "memory")
#define G8_WAIT_L(n) asm volatile("s_waitcnt lgkmcnt(" #n ")" ::: "memory")
#define G8_BAR __builtin_amdgcn_s_barrier()
#define G8_SCHED __builtin_amdgcn_sched_barrier(0)
#pragma unroll
  for (int a = 0; a < 2; ++a)
#pragma unroll
    for (int b = 0; b < 2; ++b)
#pragma unroll
      for (int m = 0; m < 4; ++m)
#pragma unroll
        for (int n = 0; n < 2; ++n) acc[a][b][m][n] = (f32x4){0.f, 0.f, 0.f, 0.f};
  bf16x8 At[4][2], B0[2][2], B1[2][2];
  G8_WAIT_V(0);
  G8_STAGE(G8_SB(0, 0), G8_BK(0), voffB); G8_STAGE(G8_SA(0, 0), G8_AK(0), voffA);
  G8_STAGE(G8_SB(0, 1), G8_BK(0) + hB, voffB); G8_STAGE(G8_SA(0, 1), G8_AK(0) + hA, voffA);
  if (wr == 1) G8_BAR;
  G8_WAIT_V(4); G8_BAR;
  G8_STAGE(G8_SB(1, 0), G8_BK(1), voffB); G8_STAGE(G8_SA(1, 0), G8_AK(1), voffA); G8_STAGE(G8_SB(1, 1), G8_BK(1) + hB, voffB);
  G8_WAIT_V(6); G8_BAR;
  for (int t = 0; t < nt - 2; t += 2) {
    const char* a1 = G8_AK(t + 1); const char* a2 = G8_AK(t + 2); const char* a3 = G8_AK(t + 3);
    const char* b2 = G8_BK(t + 2); const char* b3 = G8_BK(t + 3);
    G8_LDB(B0, 0, 0); G8_SCHED; G8_LDA(At, 0, 0); G8_STAGE(G8_SA(1, 1), a1 + hA, voffA);
    G8_WAIT_L(8); G8_BAR; G8_WAIT_L(0); G8_MMA(0, 0, At, B0); G8_BAR; G8_SCHED;
    G8_LDB(B1, 0, 1); G8_STAGE(G8_SB(0, 0), b2, voffB);
    G8_BAR; G8_WAIT_L(0); G8_MMA(0, 1, At, B1); G8_BAR;
    G8_LDA(At, 0, 1); G8_STAGE(G8_SA(0, 0), a2, voffA);
    G8_BAR; G8_WAIT_L(0); G8_MMA(1, 0, At, B0); G8_BAR; G8_SCHED;
    G8_STAGE(G8_SB(0, 1), b2 + hB, voffB);
    G8_WAIT_V(6); G8_BAR; G8_MMA(1, 1, At, B1); G8_BAR;
    G8_LDB(B0, 1, 0); G8_SCHED; G8_LDA(At, 1, 0); G8_STAGE(G8_SA(0, 1), a2 + hA, voffA);
    G8_WAIT_L(8); G8_BAR; G8_WAIT_L(0); G8_MMA(0, 0, At, B0); G8_BAR; G8_SCHED;
    G8_LDB(B1, 1, 1); G8_STAGE(G8_SB(1, 0), b3, voffB);
    G8_BAR; G8_WAIT_L(0); G8_MMA(0, 1, At, B1); G8_BAR;
    G8_LDA(At, 1, 1); G8_STAGE(G8_SA(1, 0), a3, voffA);
    G8_BAR; G8_WAIT_L(0); G8_MMA(1, 0, At, B0); G8_BAR; G8_SCHED;
    G8_STAGE(G8_SB(1, 1), b3 + hB, voffB);
    G8_WAIT_V(6); G8_BAR; G8_MMA(1, 1, At, B1); G8_BAR;
  }
  {
    G8_LDB(B0, 0, 0); G8_LDA(At, 0, 0); G8_STAGE(G8_SA(1, 1), G8_AK(nt - 1) + hA, voffA);
    G8_BAR; G8_WAIT_L(0); G8_MMA(0, 0, At, B0); G8_BAR;
    G8_LDB(B1, 0, 1); G8_BAR; G8_WAIT_L(0); G8_MMA(0, 1, At, B1); G8_BAR;
    G8_LDA(At, 0, 1); G8_WAIT_V(4); G8_BAR; G8_WAIT_L(0); G8_MMA(1, 0, At, B0); G8_MMA(1, 1, At, B1); G8_BAR;
  }
  {
    G8_LDB(B0, 1, 0); G8_LDA(At, 1, 0); G8_WAIT_V(2); G8_BAR; G8_WAIT_L(0); G8_MMA(0, 0, At, B0); G8_BAR;
    G8_LDB(B1, 1, 1); G8_WAIT_V(0); G8_BAR; G8_WAIT_L(0); G8_MMA(0, 1, At, B1); G8_BAR;
    G8_LDA(At, 1, 1); G8_BAR; G8_WAIT_L(0); G8_MMA(1, 0, At, B0); G8_MMA(1, 1, At, B1); G8_BAR;
  }
  if (wr == 0) G8_BAR;
  __syncthreads();
}

DI void transpose_tile(const float* __restrict__ src, int N, int Kd, u16* __restrict__ dst, int k0, int n0, int nd0, char* smem, const int tid, const float* __restrict__ kscale = nullptr) {
  float* sT = (float*)smem;
  {
    const int kk = tid >> 3, seg = tid & 7;
    const float4* s4 = (const float4*)(src + (size_t)(k0 + kk) * N + n0 + seg * 8);
    float4 a = s4[0], b = s4[1];
    if (kscale) { const float ks = kscale[k0 + kk]; a.x *= ks; a.y *= ks; a.z *= ks; a.w *= ks; b.x *= ks; b.y *= ks; b.z *= ks; b.w *= ks; }
    float* d = sT + kk * 65 + seg * 8;
    d[0] = a.x; d[1] = a.y; d[2] = a.z; d[3] = a.w; d[4] = b.x; d[5] = b.y; d[6] = b.z; d[7] = b.w;
  }
  __syncthreads();
  {
    const int nn = tid >> 3, seg = tid & 7;
    float v[8];
#pragma unroll
    for (int j = 0; j < 8; ++j) v[j] = sT[(seg * 8 + j) * 65 + nn];
    uint4 o;
    o.x = pack2(v[0], v[1]); o.y = pack2(v[2], v[3]); o.z = pack2(v[4], v[5]); o.w = pack2(v[6], v[7]);
    *(uint4*)(dst + (size_t)(nd0 + nn) * Kd + k0 + seg * 8) = o;
  }
  __syncthreads();
}

DI void phase0(const int wave_s, const Params& p, char* smem, const bool skipmod) {
  unsigned char* ws = launder_p(p.ws);
  float* mod = (float*)(ws + WS_MOD);
  const int tid = launder_v(launder_s(wave_s) * 64 + (int)__builtin_amdgcn_mbcnt_hi(launder_s(-1), __builtin_amdgcn_mbcnt_lo(-1, 0)));
  constexpr int I_MOD = 384;
  constexpr int I_WIN = I_MOD + 2400;
  constexpr int I_WOUT = I_WIN + 1024;
  constexpr int I_WUQ = I_WOUT + 144;
  constexpr int I_WUK = I_WUQ + 64;
  constexpr int I_WUV = I_WUK + 64;
  constexpr int I_TAB = I_WUV + 514;
  constexpr int I_CK = I_TAB + 128;
  constexpr int I_PAD = I_CK + 32;
  for (int item = launder_s(blockIdx.x) + (skipmod ? 384 : 0); item < I_PAD; item += gridDim.x) {
    if (item < I_MOD) {
      const int ct = item % 24, kcn = item / 24;
      const int k0 = kcn * 128;
      float* sc = (float*)smem;
      for (int i = tid; i < 9 * 128; i += 512) {
        const int rr = i >> 7, kk = i & 127;
        const float v = (rr < 8) ? p.c[rr * 2048 + k0 + kk] : p.c_ctx[k0 + kk];
        sc[i] = silu(v);
      }
      __syncthreads();
      const int col = ct * 256 + (tid & 255), kh = tid >> 8;
      float a[9];
#pragma unroll
      for (int rr = 0; rr < 9; ++rr) a[rr] = 0.f;
      const float* wp = p.w_mod + (size_t)(k0 + kh * 64) * 6144 + col;
#pragma unroll 8
      for (int kk = 0; kk < 64; ++kk) {
        const float w = wp[(size_t)kk * 6144];
#pragma unroll
        for (int rr = 0; rr < 9; ++rr) a[rr] += sc[rr * 128 + kh * 64 + kk] * w;
      }
      const float bias = (kcn == 0 && kh == 0) ? p.b_mod[col] : 0.f;
#pragma unroll
      for (int rr = 0; rr < 9; ++rr) atomicAdd(mod + rr * 6144 + col, a[rr] + bias);
      __syncthreads();
    } else if (item < I_WIN) {
      const int t = item - I_MOD;
      const int kt = t % 32, ntile = t / 32;
      const int n0 = ntile * 64;
      const int nd0 = (n0 < 704) ? (n0 + 4096) : (n0 - 704);
      transpose_tile(p.w_in, 4800, 2048, (u16*)(ws + WS_WIT), kt * 64, n0, nd0, smem, tid);
    } else if (item < I_WOUT) {
      const int t = item - I_WIN;
      transpose_tile(p.w_out, 2048, 2048, (u16*)(ws + WS_WOT), (t % 32) * 64, (t / 32) * 64, (t / 32) * 64, smem, tid);
    } else if (item < I_WUQ) {
      const int t = item - I_WOUT;
      transpose_tile(p.w_uq, 1536, 384, (u16*)(ws + WS_WUQT), (t % 6) * 64, (t / 6) * 64, (t / 6) * 64, smem, tid, p.q_norm_w);
    } else if (item < I_WUK) {
      const int t = item - I_WUQ;
      transpose_tile(p.w_uk, 1024, 256, (u16*)(ws + WS_WUKT), (t % 4) * 64, (t / 4) * 64, (t / 4) * 64, smem, tid, p.kv_norm_w);
    } else if (item < I_WUV) {
      const int t = item - I_WUK;
      transpose_tile(p.w_uv, 1024, 256, (u16*)(ws + WS_WUVT), (t % 4) * 64, (t / 4) * 64, (t / 4) * 64, smem, tid, p.kv_norm_w);
    } else if (item < I_TAB) {
      const int t = item - I_WUV;
      if (t < 2) {
        const int idx = t * 512 + tid;
        const int pos = idx >> 4, i = idx & 15;
        const double fr = exp2(-(double)i / 16.0 * 13.287712379549449);
        float s, c;
        sincos_acc((double)pos * fr, s, c);
        ((float2*)(ws + WS_ROPE2D))[idx] = make_float2(c, s);
      } else {
        const int idx = (t - 2) * 512 + tid;
        const int pos = idx >> 6, i = idx & 63;
        const double fr = exp2(-(double)i / 64.0 * 13.287712379549449);
        float s, c;
        sincos_acc((double)pos * fr, s, c);
        ((float2*)(ws + WS_ROPER))[idx] = make_float2(c, s);
      }
    } else if (item < I_CK) {
      const int t = item - I_TAB;
      const size_t e0 = (size_t)t * 4096 + tid * 8;
      const float4* s4 = (const float4*)(p.cache_ckv + e0);
      float4 a = s4[0], b = s4[1];
      const float4 w0 = *(const float4*)(p.kv_norm_w + ((tid * 8) & 255)), w1 = *(const float4*)(p.kv_norm_w + ((tid * 8) & 255) + 4);
      uint4 o;
      o.x = pack2(a.x / w0.x, a.y / w0.y); o.y = pack2(a.z / w0.z, a.w / w0.w); o.z = pack2(b.x / w1.x, b.y / w1.y); o.w = pack2(b.z / w1.z, b.w / w1.w);
      *(uint4*)((u16*)(ws + WS_CK) + e0) = o;
    } else {
      const int t = item - I_CK;
      const size_t e0 = (size_t)4800 * 2048 + (size_t)t * 4096 + tid * 8;
      const unsigned z = (unsigned)launder_v(0);
      *(uint4*)((u16*)(ws + WS_WIT) + e0) = make_uint4(z, z, z, z);
    }
  }
}

DI void phase1(const int wave_s, const Params& p) {
  const float* mod = (const float*)(launder_p(p.ws) + WS_MOD);
  u16* H = (u16*)(launder_p(p.ws) + WS_H);
  const int tid = launder_v(launder_s(wave_s) * 64 + (int)__builtin_amdgcn_mbcnt_hi(launder_s(-1), __builtin_amdgcn_mbcnt_lo(-1, 0)));
  const int lane = tid & 63, wave = tid >> 6;
  for (int row = launder_s(blockIdx.x) * 8 + wave; row < NT; row += gridDim.x * 8) {
    const float* x = (row < NTP) ? (p.x_prompt + (size_t)row * D) : (p.x_sample + (size_t)(row - NTP) * D);
    const int mrow = (row < NTP) ? 8 : ((row - NTP) >> 12);
    const float* shift = mod + mrow * 6144;
    const float* scale = shift + 2048;
    float4 v[8];
    float ss = 0.f;
#pragma unroll
    for (int j = 0; j < 8; ++j) {
      v[j] = ((const float4*)x)[j * 64 + lane];
      ss += v[j].x * v[j].x + v[j].y * v[j].y + v[j].z * v[j].z + v[j].w * v[j].w;
    }
#pragma unroll
    for (int o = 32; o >= 1; o >>= 1) ss += shx(ss, o, tid);
    const float rstd = rsqrtf(ss * (1.f / 2048.f) + EPSF);
#pragma unroll
    for (int j = 0; j < 8; ++j) {
      const int c4 = j * 64 + lane;
      const float4 nw = ((const float4*)p.norm_w)[c4];
      const float4 sc = ((const float4*)scale)[c4];
      const float4 sh = ((const float4*)shift)[c4];
      const float a0 = v[j].x * rstd * nw.x * (1.f + sc.x) + sh.x;
      const float a1 = v[j].y * rstd * nw.y * (1.f + sc.y) + sh.y;
      const float a2 = v[j].z * rstd * nw.z * (1.f + sc.z) + sh.z;
      const float a3 = v[j].w * rstd * nw.w * (1.f + sc.w) + sh.w;
      uint2 o;
      o.x = pack2(a0, a1); o.y = pack2(a2, a3);
      *(uint2*)(H + (size_t)row * D + c4 * 4) = o;
    }
  }
}

DI void p2_tile(const int wave_s, const Params& p, char* smem, const int tok0, const int nt) {
  unsigned char* ws = launder_p(p.ws);
  const u16* H = (const u16*)(ws + WS_H);
  const u16* WiT = (const u16*)(ws + WS_WIT);
  const float2* ropeR = (const float2*)(ws + WS_ROPER);
  const int tid = launder_v(launder_s(wave_s) * 64 + (int)__builtin_amdgcn_mbcnt_hi(launder_s(-1), __builtin_amdgcn_mbcnt_lo(-1, 0))), lane = tid & 63, wave = tid >> 6;
  const int r = lane & 31, hh = lane >> 5;
  const int n0 = nt * 256;
  const bool sample = tok0 >= NTP;
  const int L = sample ? LS : LP;
  const int bb = sample ? ((tok0 - NTP) >> 12) : (tok0 >> 8);
  const int pos0 = sample ? ((tok0 - NTP) & 4095) : 0;
  f32x4 acc[2][2][4][2];
  gemm8p(acc, WiT + (size_t)n0 * D, D, H + (size_t)tok0 * D, H, 1 << 30, D, 32, smem, tid);
  const int wr = wave >> 2, wc = wave & 3, fr = lane & 15, fq = lane >> 4;
  const bool is_rk = (nt == 6 || nt == 7), is_rq = (nt == 4 || nt == 5);
  if (is_rk) {
#pragma unroll
    for (int a = 0; a < 2; ++a)
#pragma unroll
      for (int b = 0; b < 2; ++b)
#pragma unroll
        for (int m = 0; m < 4; ++m)
#pragma unroll
          for (int n = 0; n < 2; ++n) acc[a][b][m][n] *= 0.08838834764831845f;
  }
  if (nt == 18 && !sample && wr == 0) {
#pragma unroll
    for (int b = 0; b < 2; ++b)
#pragma unroll
      for (int n = 0; n < 2; ++n) {
        float* od = p.out + OUT_KROPE + (size_t)(tok0 + b * 128 + wc * 32 + n * 16 + fr) * 64 + fq * 4;
#pragma unroll
        for (int m = 0; m < 4; ++m) *(f32x4*)(od + m * 16) = acc[1][b][m][n];
      }
  }
#pragma unroll
  for (int b = 0; b < 2; ++b)
#pragma unroll
    for (int n = 0; n < 2; ++n) {
      char* d = smem + (b * 128 + wc * 32 + n * 16 + fr) * 528 + (wr * 64 + fq * 4) * 2;
#pragma unroll
      for (int a = 0; a < 2; ++a)
#pragma unroll
        for (int m = 0; m < 4; ++m) {
          uint2 o;
          o.x = pack2(acc[a][b][m][n][0], acc[a][b][m][n][1]); o.y = pack2(acc[a][b][m][n][2], acc[a][b][m][n][3]);
          *(uint2*)(d + (a * 128 + m * 16) * 2) = o;
        }
    }
  __syncthreads();
  if ((is_rk || is_rq) && sample) {
#pragma unroll 2
    for (int c = 0; c < 8; ++c) {
      const int u = tid + 512 * c;
      const int row = u >> 4, hp2 = (u >> 3) & 1, ch = u & 7;
      char* a = smem + row * 528 + (hp2 * 128 + ch * 8) * 2;
      const uint4 x1 = *(const uint4*)a, x2 = *(const uint4*)(a + 128);
      const float4* cp = (const float4*)(ropeR + (size_t)(pos0 + row) * 64 + ch * 8);
      const float4 t0 = cp[0], t1 = cp[1], t2 = cp[2], t3 = cp[3];
      const float cs[8] = {t0.x, t0.z, t1.x, t1.z, t2.x, t2.z, t3.x, t3.z};
      const float sn[8] = {t0.y, t0.w, t1.y, t1.w, t2.y, t2.w, t3.y, t3.w};
      const unsigned w1[4] = {x1.x, x1.y, x1.z, x1.w}, w2[4] = {x2.x, x2.y, x2.z, x2.w};
      unsigned o1[4], o2[4];
#pragma unroll
      for (int j = 0; j < 4; ++j) {
        const float a0 = bflo(w1[j]), a1 = bfhi(w1[j]), b0 = bflo(w2[j]), b1 = bfhi(w2[j]);
        o1[j] = pack2(a0 * cs[2 * j] - b0 * sn[2 * j], a1 * cs[2 * j + 1] - b1 * sn[2 * j + 1]);
        o2[j] = pack2(b0 * cs[2 * j] + a0 * sn[2 * j], b1 * cs[2 * j + 1] + a1 * sn[2 * j + 1]);
      }
      *(uint4*)a = make_uint4(o1[0], o1[1], o1[2], o1[3]);
      *(uint4*)(a + 128) = make_uint4(o2[0], o2[1], o2[2], o2[3]);
    }
    __syncthreads();
  }
  if (!(nt >= 8 && nt < 12)) {
    u16* dst; int ldo, c0, clim = 256;
    if (nt < 4) { dst = (u16*)(ws + WS_G); ldo = 2048; c0 = n0; }
    else if (nt < 6) { dst = (u16*)(ws + WS_RQ); ldo = 512; c0 = n0 - 1024; }
    else if (nt < 8) { dst = (u16*)(ws + WS_RK); ldo = 512; c0 = n0 - 1536; }
    else if (nt < 16) { dst = (u16*)(ws + WS_G); ldo = 2048; c0 = n0 - 2048; }
    else { dst = (u16*)(ws + WS_PS); ldo = PSW; c0 = n0 - 4096; clim = PSW - c0; }
    const int part = tid & 31, row0 = tid >> 5;
    if (part * 8 < clim) {
      u16* dp = dst + (size_t)(tok0 + row0) * ldo + c0 + part * 8;
      const char* sp = smem + row0 * 528 + part * 16;
#pragma unroll 2
      for (int c = 0; c < 16; ++c) *(uint4*)(dp + (size_t)c * 16 * ldo) = *(const uint4*)(sp + c * 16 * 528);
    }
  }
  if (nt >= 6 && nt < 12) {
    u16* T; size_t rowbase;
    if (nt < 8) { T = (u16*)(ws + WS_RKT) + (sample ? RKT_S_OFF : 0); rowbase = (size_t)bb * 512 + (nt - 6) * 256; }
    else { T = (u16*)(ws + WS_RVT) + (sample ? RVT_S_OFF : 0); rowbase = (size_t)bb * 1024 + (nt - 8) * 256; }
    const int f_lo = tid & 15, tg = (tid >> 4) & 31;
#pragma unroll 1
    for (int c = 0; c < 16; ++c) {
      const int f = c * 16 + f_lo;
      const char* sp = smem + (tg * 8) * 528 + f * 2;
      unsigned short v[8];
#pragma unroll
      for (int j = 0; j < 8; ++j) v[j] = *(const u16*)(sp + j * 528);
      uint4 o;
      o.x = v[0] | ((unsigned)v[1] << 16); o.y = v[2] | ((unsigned)v[3] << 16);
      o.z = v[4] | ((unsigned)v[5] << 16); o.w = v[6] | ((unsigned)v[7] << 16);
      *(uint4*)(T + (rowbase + f) * L + pos0 + tg * 8) = o;
    }
  }
  __syncthreads();
}

DI void phase2(const int wave_s, const Params& p, char* smem) {
  const int xcd = launder_s(blockIdx.x) & 7, bi = launder_s(blockIdx.x) >> 3, nb = gridDim.x >> 3;
  if (bi >= nb) return;
  for (int pos = xcd * 380 + bi; pos < (xcd + 1) * 380; pos += nb) {
    const int mg = pos / 152, pim = pos % 152;
    int ng, i;
    if (pim < 128) { ng = pim >> 5; i = pim & 31; } else { ng = 4; i = pim - 128; }
    const int mt = mg * 8 + (i & 7), nt = ng * 4 + (i >> 3);
    const int tok0 = mt * 256;
    p2_tile(wave_s, p, smem, tok0, nt);
  }
}

DI void p3_q8(const int wave_s, const Params& p, char* smem, const int tb, const int half) {
  unsigned char* ws = launder_p(p.ws);
  const u16* Ps = (const u16*)(ws + WS_PS);
  const u16* WuqT = (const u16*)(ws + WS_WUQT);
  u16* Qg = (u16*)(ws + WS_Q);
  float* QF = (float*)(ws + WS_QF);
  const float2* rope2d = (const float2*)(ws + WS_ROPE2D);
  const int tid = launder_v(launder_s(wave_s) * 64 + (int)__builtin_amdgcn_mbcnt_hi(launder_s(-1), __builtin_amdgcn_mbcnt_lo(-1, 0)));
  const int tok0 = tb * 256;
  const bool sample = tok0 >= NTP;
  const int bb = sample ? ((tok0 - NTP) >> 12) : (tok0 >> 8);
  const int pos0 = sample ? ((tok0 - NTP) & 4095) : 0;
  const int L = sample ? LS : LP;
  const size_t qoff = sample ? Q_S_OFF : 0;
  float* msq = (float*)(smem + 135168);
  float* ssq = msq + 256;
  {
    const int row = tid >> 1, hf = tid & 1;
    const u16* src = Ps + (size_t)(tok0 + row) * PSW + hf * 192;
    float ss = 0.f;
#pragma unroll 2
    for (int g = 0; g < 2; ++g) {
      uint4 v[12];
#pragma unroll
      for (int j = 0; j < 12; ++j) v[j] = *(const uint4*)(src + g * 96 + j * 8);
#pragma unroll
      for (int j = 0; j < 12; ++j) {
        const unsigned w[4] = {v[j].x, v[j].y, v[j].z, v[j].w};
#pragma unroll
        for (int q = 0; q < 4; ++q) { const float a = bflo(w[q]), b = bfhi(w[q]); ss += a * a + b * b; }
      }
    }
    ss += shx(ss, 1, tid);
    if (hf == 0) msq[row] = ss * (1.f / 384.f);
    ssq[tid] = 0.f;
    ssq[tid + 512] = 0.f;
  }
  __syncthreads();
  const float qscale = 0.07216878364870322f * LOG2E;
#pragma unroll 1
  for (int ft = 0; ft < 3; ++ft) {
    const int Fbase = half * 768 + ft * 256;
    f32x4 acc[2][2][4][2];
    gemm8p(acc, WuqT + (size_t)Fbase * 384, 384, Ps + (size_t)tok0 * PSW, Ps, 1 << 30, PSW, 6, smem, launder_v(tid));
    const int tid2 = launder_v(tid), lane = tid2 & 63, wave = __builtin_amdgcn_readfirstlane(tid2 >> 6);
    const int wr = wave >> 2, wc = wave & 3, fr = lane & 15, fq = lane >> 4;
#pragma unroll
    for (int ai = 0; ai < 2; ++ai) {
      const int g0 = Fbase + ai * 128 + wr * 64;
      const int hl = g0 / 192 - half * 4, d0 = g0 % 192;
#pragma unroll
      for (int bj = 0; bj < 2; ++bj)
#pragma unroll
        for (int n = 0; n < 2; ++n) {
          float s = 0.f;
#pragma unroll
          for (int m = 0; m < 4; ++m)
#pragma unroll
            for (int j = 0; j < 4; ++j) s += acc[ai][bj][m][n][j] * acc[ai][bj][m][n][j];
          s += shx(s, 16, tid2);
          s += shx(s, 32, tid2);
          if (fq == 0) atomicAdd(&ssq[(bj * 128 + wc * 32 + n * 16 + fr) * 4 + hl], s);
        }
#pragma unroll
      for (int m = 0; m < 4; ++m) {
        const f32x4 w4 = *(const f32x4*)(p.qk_q_w + d0 + m * 16 + fq * 4);
#pragma unroll
        for (int bj = 0; bj < 2; ++bj)
#pragma unroll
          for (int n = 0; n < 2; ++n) acc[ai][bj][m][n] *= w4;
      }
      if (sample && d0 == 128) {
#pragma unroll
        for (int bj = 0; bj < 2; ++bj)
#pragma unroll
          for (int n = 0; n < 2; ++n) {
            const int ps = pos0 + bj * 128 + wc * 32 + n * 16 + fr;
            const float4* cr = (const float4*)(rope2d + (ps >> 6) * 16 + fq * 4);
            const float4* cc = (const float4*)(rope2d + (ps & 63) * 16 + fq * 4);
            const float4 r0 = cr[0], r1 = cr[1], c0 = cc[0], c1 = cc[1];
            const float rc[4] = {r0.x, r0.z, r1.x, r1.z}, rs[4] = {r0.y, r0.w, r1.y, r1.w};
            const float ccs[4] = {c0.x, c0.z, c1.x, c1.z}, csn[4] = {c0.y, c0.w, c1.y, c1.w};
#pragma unroll
            for (int j = 0; j < 4; ++j) {
              const float x1 = acc[ai][bj][0][n][j], x2 = acc[ai][bj][1][n][j];
              acc[ai][bj][0][n][j] = x1 * rc[j] - x2 * rs[j];
              acc[ai][bj][1][n][j] = x2 * rc[j] + x1 * rs[j];
              const float y1 = acc[ai][bj][2][n][j], y2 = acc[ai][bj][3][n][j];
              acc[ai][bj][2][n][j] = y1 * ccs[j] - y2 * csn[j];
              acc[ai][bj][3][n][j] = y2 * ccs[j] + y1 * csn[j];
            }
          }
      }
#pragma unroll
      for (int bj = 0; bj < 2; ++bj)
#pragma unroll
        for (int n = 0; n < 2; ++n) {
          char* d = smem + (bj * 128 + wc * 32 + n * 16 + fr) * 528 + (ai * 128 + wr * 64 + fq * 4) * 2;
#pragma unroll
          for (int m = 0; m < 4; ++m) {
            const f32x4 v = acc[ai][bj][m][n] * qscale;
            uint2 o;
            o.x = pack2(v[0], v[1]); o.y = pack2(v[2], v[3]);
            *(uint2*)(d + m * 32) = o;
          }
        }
    }
    __syncthreads();
    {
      const int part = tid2 & 31, row0 = tid2 >> 5;
      const int F0 = Fbase + part * 8;
      const int head = F0 / 192, d = F0 % 192;
      u16* dst = Qg + qoff + ((size_t)(bb * 8 + head) * L + pos0 + row0) * 192 + d;
      const char* sp = smem + row0 * 528 + part * 16;
#pragma unroll 4
      for (int c = 0; c < 16; ++c) *(uint4*)(dst + (size_t)c * 16 * 192) = *(const uint4*)(sp + c * 16 * 528);
    }
    __syncthreads();
  }
  if (tid < 256) {
    const int tid2 = tid;
    const float e2 = EPSF * (msq[tid2] + EPSF);
    float4 o;
    o.x = rsqrtf(ssq[tid2 * 4 + 0] * (1.f / 192.f) + e2);
    o.y = rsqrtf(ssq[tid2 * 4 + 1] * (1.f / 192.f) + e2);
    o.z = rsqrtf(ssq[tid2 * 4 + 2] * (1.f / 192.f) + e2);
    o.w = rsqrtf(ssq[tid2 * 4 + 3] * (1.f / 192.f) + e2);
    *(float4*)(QF + (size_t)(tok0 + tid2) * 8 + half * 4) = o;
  }
  __syncthreads();
}

DI void p3_kv8(const int wave_s, const Params& p, char* smem, const int tbk, const bool isV) {
  unsigned char* ws = launder_p(p.ws);
  const u16* Ps = (const u16*)(ws + WS_PS);
  const u16* Wkv = (const u16*)(ws + WS_WUKT) + (isV ? (size_t)1024 * 256 : 0);
  u16* Kg = (u16*)(ws + WS_K);
  u16* Vtg = (u16*)(ws + WS_VT);
  const float2* rope2d = (const float2*)(ws + WS_ROPE2D);
  const int tid = launder_v(launder_s(wave_s) * 64 + (int)__builtin_amdgcn_mbcnt_hi(launder_s(-1), __builtin_amdgcn_mbcnt_lo(-1, 0)));
  const bool ctx = tbk >= 160;
  const int tok0 = ctx ? (tbk - 160) * 256 : tbk * 256;
  const bool sample = ctx || tok0 >= NTP;
  const bool dorope = sample && !ctx;
  int bb, pos0, key0, NK;
  size_t koff, voff;
  if (ctx) { bb = tbk - 160; pos0 = 0; key0 = 4096; NK = NKS; koff = K_S_OFF; voff = VT_S_OFF; }
  else if (sample) { bb = (tok0 - NTP) >> 12; pos0 = (tok0 - NTP) & 4095; key0 = pos0; NK = NKS; koff = K_S_OFF; voff = VT_S_OFF; }
  else { bb = tok0 >> 8; pos0 = 0; key0 = 0; NK = LP; koff = 0; voff = 0; }
  const u16* Bsrc = ctx ? ((const u16*)(ws + WS_CK) + (size_t)tok0 * 256) : (Ps + (size_t)tok0 * PSW + 384);
  const int ldb = ctx ? 256 : PSW;
  float* rstdc = (float*)(smem + 135168);
  float* krss = rstdc + 256;
  float* ssqk = krss + 256;
  {
    const int row = tid >> 1, hf = tid & 1;
    if (!ctx) {
      const u16* src = Ps + (size_t)(tok0 + row) * PSW + 384 + hf * 128;
      uint4 v[16];
      float ss = 0.f;
#pragma unroll
      for (int j = 0; j < 16; ++j) v[j] = *(const uint4*)(src + j * 8);
#pragma unroll
      for (int j = 0; j < 16; ++j) {
        const unsigned w[4] = {v[j].x, v[j].y, v[j].z, v[j].w};
#pragma unroll
        for (int q = 0; q < 4; ++q) { const float a = bflo(w[q]), b = bfhi(w[q]); ss += a * a + b * b; }
      }
      ss += shx(ss, 1, tid);
      const float rstd = rsqrtf(ss * (1.f / 256.f) + EPSF);
      if (hf == 0) rstdc[row] = rstd;
      if (!isV && tok0 < NTP) {
        float* od = p.out + OUT_CKV + (size_t)(tok0 + row) * 256 + hf * 128;
#pragma unroll
        for (int j = 0; j < 16; ++j) {
          const float4 n0 = *(const float4*)(p.kv_norm_w + hf * 128 + j * 8), n1 = *(const float4*)(p.kv_norm_w + hf * 128 + j * 8 + 4);
          *(float4*)(od + j * 8) = make_float4(bflo(v[j].x) * rstd * n0.x, bfhi(v[j].x) * rstd * n0.y, bflo(v[j].y) * rstd * n0.z, bfhi(v[j].y) * rstd * n0.w);
          *(float4*)(od + j * 8 + 4) = make_float4(bflo(v[j].z) * rstd * n1.x, bfhi(v[j].z) * rstd * n1.y, bflo(v[j].w) * rstd * n1.z, bfhi(v[j].w) * rstd * n1.w);
        }
      }
      if (!isV) {
        const u16* ks = Ps + (size_t)(tok0 + row) * PSW + 640 + hf * 32;
        float s2 = 0.f;
#pragma unroll
        for (int j = 0; j < 4; ++j) {
          const uint4 a = *(const uint4*)(ks + j * 8);
          const unsigned w[4] = {a.x, a.y, a.z, a.w};
#pragma unroll
          for (int q = 0; q < 4; ++q) { const float x = bflo(w[q]), y = bfhi(w[q]); s2 += x * x + y * y; }
        }
        s2 += shx(s2, 1, tid);
        if (hf == 0) krss[row] = s2;
      }
    } else {
      if (hf == 0) rstdc[row] = 1.f;
      if (!isV) {
        const float* ks = p.cache_krope + (size_t)(tok0 + row) * 64 + hf * 32;
        float s2 = 0.f;
#pragma unroll
        for (int j = 0; j < 8; ++j) {
          const float4 a = *(const float4*)(ks + j * 4);
          const float x0 = bf2f(f2bf(a.x)), x1 = bf2f(f2bf(a.y)), x2 = bf2f(f2bf(a.z)), x3 = bf2f(f2bf(a.w));
          s2 += x0 * x0 + x1 * x1 + x2 * x2 + x3 * x3;
        }
        s2 += shx(s2, 1, tid);
        if (hf == 0) krss[row] = s2;
      }
    }
#pragma unroll
    for (int j = 0; j < 4; ++j) ssqk[tid + 512 * j] = 0.f;
  }
  __syncthreads();
#pragma unroll 1
  for (int ft = 0; ft < 4; ++ft) {
    f32x4 acc[2][2][4][2];
    gemm8p(acc, Wkv + (size_t)ft * 256 * 256, 256, Bsrc, Bsrc, 1 << 30, ldb, 4, smem, launder_v(tid));
    const int tid2 = launder_v(tid), lane = tid2 & 63, wave = __builtin_amdgcn_readfirstlane(tid2 >> 6);
    const int wr = wave >> 2, wc = wave & 3, fr = lane & 15, fq = lane >> 4;
    if (!isV) {
#pragma unroll
      for (int ai = 0; ai < 2; ++ai) {
#pragma unroll
        for (int bj = 0; bj < 2; ++bj)
#pragma unroll
          for (int n = 0; n < 2; ++n) {
            float s = 0.f;
#pragma unroll
            for (int m = 0; m < 4; ++m)
#pragma unroll
              for (int j = 0; j < 4; ++j) s += acc[ai][bj][m][n][j] * acc[ai][bj][m][n][j];
            s += shx(s, 16, tid2);
            s += shx(s, 32, tid2);
            if (fq == 0) atomicAdd(&ssqk[(bj * 128 + wc * 32 + n * 16 + fr) * 8 + ft * 2 + ai], s);
          }
#pragma unroll
        for (int m = 0; m < 4; ++m) {
          const f32x4 w4 = *(const f32x4*)(p.qk_k_w + wr * 64 + m * 16 + fq * 4);
#pragma unroll
          for (int bj = 0; bj < 2; ++bj)
#pragma unroll
            for (int n = 0; n < 2; ++n) acc[ai][bj][m][n] *= w4;
        }
      }
    } else {
#pragma unroll
      for (int bj = 0; bj < 2; ++bj)
#pragma unroll
        for (int n = 0; n < 2; ++n) {
          const float rc = rstdc[bj * 128 + wc * 32 + n * 16 + fr];
#pragma unroll
          for (int ai = 0; ai < 2; ++ai)
#pragma unroll
            for (int m = 0; m < 4; ++m) acc[ai][bj][m][n] *= rc;
        }
    }
#pragma unroll
    for (int bj = 0; bj < 2; ++bj)
#pragma unroll
      for (int n = 0; n < 2; ++n) {
        char* d = smem + (bj * 128 + wc * 32 + n * 16 + fr) * 528 + (wr * 64 + fq * 4) * 2;
#pragma unroll
        for (int ai = 0; ai < 2; ++ai)
#pragma unroll
          for (int m = 0; m < 4; ++m) {
            uint2 o;
            o.x = pack2(acc[ai][bj][m][n][0], acc[ai][bj][m][n][1]); o.y = pack2(acc[ai][bj][m][n][2], acc[ai][bj][m][n][3]);
            *(uint2*)(d + (ai * 128 + m * 16) * 2) = o;
          }
      }
    __syncthreads();
    if (!isV) {
      {
        const int part = tid2 & 31, row0 = tid2 >> 5;
        const int ai = part >> 4, d = (part & 15) * 8;
        u16* dst = Kg + koff + ((size_t)(bb * 8 + ft * 2 + ai) * NK + key0 + row0) * 192 + d;
#pragma unroll 4
        for (int c = 0; c < 16; ++c) {
          const int row = row0 + c * 16;
          const float rc = rstdc[row];
          const float rinv = rsqrtf((rc * rc * ssqk[row * 8 + ft * 2 + ai] + krss[row]) * (1.f / 192.f) + EPSF);
          const float f = rc * rinv;
          const uint4 v = *(const uint4*)(smem + row * 528 + part * 16);
          uint4 o;
          o.x = pack2(bflo(v.x) * f, bfhi(v.x) * f); o.y = pack2(bflo(v.y) * f, bfhi(v.y) * f);
          o.z = pack2(bflo(v.z) * f, bfhi(v.z) * f); o.w = pack2(bflo(v.w) * f, bfhi(v.w) * f);
          *(uint4*)(dst + (size_t)c * 16 * 192) = o;
        }
      }
#pragma unroll 2
      for (int c = 0; c < 4; ++c) {
        const int u = tid2 + 512 * c;
        const int row = u >> 3, ai = (u >> 2) & 1, q = u & 3;
        const int axis = q >> 1, jb = (q & 1) * 8;
        float x1[8], x2[8];
        if (ctx) {
          const float* ks = p.cache_krope + (size_t)(tok0 + row) * 64 + axis * 32 + jb;
          const float4 a0 = *(const float4*)ks, a1 = *(const float4*)(ks + 4), b0 = *(const float4*)(ks + 16), b1 = *(const float4*)(ks + 20);
          x1[0] = a0.x; x1[1] = a0.y; x1[2] = a0.z; x1[3] = a0.w; x1[4] = a1.x; x1[5] = a1.y; x1[6] = a1.z; x1[7] = a1.w;
          x2[0] = b0.x; x2[1] = b0.y; x2[2] = b0.z; x2[3] = b0.w; x2[4] = b1.x; x2[5] = b1.y; x2[6] = b1.z; x2[7] = b1.w;
#pragma unroll
          for (int j = 0; j < 8; ++j) { x1[j] = bf2f(f2bf(x1[j])); x2[j] = bf2f(f2bf(x2[j])); }
        } else {
          const u16* ks = Ps + (size_t)(tok0 + row) * PSW + 640 + axis * 32 + jb;
          const uint4 a = *(const uint4*)ks, b = *(const uint4*)(ks + 16);
          x1[0] = bflo(a.x); x1[1] = bfhi(a.x); x1[2] = bflo(a.y); x1[3] = bfhi(a.y); x1[4] = bflo(a.z); x1[5] = bfhi(a.z); x1[6] = bflo(a.w); x1[7] = bfhi(a.w);
          x2[0] = bflo(b.x); x2[1] = bfhi(b.x); x2[2] = bflo(b.y); x2[3] = bfhi(b.y); x2[4] = bflo(b.z); x2[5] = bfhi(b.z); x2[6] = bflo(b.w); x2[7] = bfhi(b.w);
        }
        const float rc = rstdc[row];
        const float rinv = rsqrtf((rc * rc * ssqk[row * 8 + ft * 2 + ai] + krss[row]) * (1.f / 192.f) + EPSF);
        const float* wp = p.qk_k_w + 128 + axis * 32 + jb;
        const float4 wa0 = *(const float4*)wp, wa1 = *(const float4*)(wp + 4), wb0 = *(const float4*)(wp + 16), wb1 = *(const float4*)(wp + 20);
        const float wa[8] = {wa0.x, wa0.y, wa0.z, wa0.w, wa1.x, wa1.y, wa1.z, wa1.w};
        const float wb[8] = {wb0.x, wb0.y, wb0.z, wb0.w, wb1.x, wb1.y, wb1.z, wb1.w};
        float cs[8], sn[8];
        if (dorope) {
          const int ps = pos0 + row;
          const int pp = axis ? (ps & 63) : (ps >> 6);
          const float4* cp = (const float4*)(rope2d + pp * 16 + jb);
          const float4 t0 = cp[0], t1 = cp[1], t2 = cp[2], t3 = cp[3];
          cs[0] = t0.x; cs[1] = t0.z; cs[2] = t1.x; cs[3] = t1.z; cs[4] = t2.x; cs[5] = t2.z; cs[6] = t3.x; cs[7] = t3.z;
          sn[0] = t0.y; sn[1] = t0.w; sn[2] = t1.y; sn[3] = t1.w; sn[4] = t2.y; sn[5] = t2.w; sn[6] = t3.y; sn[7] = t3.w;
        } else {
#pragma unroll
          for (int j = 0; j < 8; ++j) { cs[j] = 1.f; sn[j] = 0.f; }
        }
        float o1[8], o2[8];
#pragma unroll
        for (int j = 0; j < 8; ++j) {
          const float a = x1[j] * wa[j] * rinv, b = x2[j] * wb[j] * rinv;
          o1[j] = a * cs[j] - b * sn[j];
          o2[j] = b * cs[j] + a * sn[j];
        }
        u16* dst = Kg + koff + ((size_t)(bb * 8 + ft * 2 + ai) * NK + key0 + row) * 192 + 128 + axis * 32 + jb;
        *(uint4*)dst = make_uint4(pack2(o1[0], o1[1]), pack2(o1[2], o1[3]), pack2(o1[4], o1[5]), pack2(o1[6], o1[7]));
        *(uint4*)(dst + 16) = make_uint4(pack2(o2[0], o2[1]), pack2(o2[2], o2[3]), pack2(o2[4], o2[5]), pack2(o2[6], o2[7]));
      }
    } else {
      u16* T = Vtg + voff + ((size_t)bb * 1024 + ft * 256) * NK + key0;
      const int f_lo = tid2 & 15, tg = tid2 >> 4;
#pragma unroll 1
      for (int c = 0; c < 16; ++c) {
        const int f = c * 16 + f_lo;
        const char* sp = smem + ((tg >> 1) * 16 + 4 * (tg & 1)) * 528 + f * 2;
        unsigned short v[8];
#pragma unroll
        for (int j = 0; j < 8; ++j) v[j] = *(const u16*)(sp + ((j & 3) + 8 * (j >> 2)) * 528);
        uint4 o;
        o.x = v[0] | ((unsigned)v[1] << 16); o.y = v[2] | ((unsigned)v[3] << 16);
        o.z = v[4] | ((unsigned)v[5] << 16); o.w = v[6] | ((unsigned)v[7] << 16);
        *(uint4*)(T + (size_t)f * NK + tg * 8) = o;
      }
    }
    __syncthreads();
  }
}

DI void phase3(const int wave_s, const Params& p, char* smem) {
  for (int item = launder_s(blockIdx.x); item < 656; item += gridDim.x) {
    if (item < 320) p3_q8(wave_s, p, smem, item >> 1, item & 1);
    else if (item < 488) p3_kv8(wave_s, p, smem, item - 320, false);
    else p3_kv8(wave_s, p, smem, item - 488, true);
  }
}

DI void phase_attn(const int wave_s, const Params& p, char* smem) {
  unsigned char* ws = launder_p(p.ws);
  const u16* Qg = (const u16*)(ws + WS_Q);
  const u16* Kg = (const u16*)(ws + WS_K);
  const u16* Vtg = (const u16*)(ws + WS_VT);
  const u16* G = (const u16*)(ws + WS_G);
  u16* mixA = (u16*)(ws + WS_MIXA);
  const int tid = launder_v(launder_s(wave_s) * 64 + (int)__builtin_amdgcn_mbcnt_hi(launder_s(-1), __builtin_amdgcn_mbcnt_lo(-1, 0))), lane = tid & 63, wave = __builtin_amdgcn_readfirstlane(tid >> 6);
  const int r = lane & 31, hh = lane >> 5;
  constexpr int KT_B = 64 * 400, VT_B = 128 * 144, ST_B = KT_B + VT_B;
  const int nblk = gridDim.x;
  for (int it = launder_s(blockIdx.x); it < 1024 + 256; it += nblk) {
    int bh, qb, L, NK, tokbase;
    const u16 *Qb, *Kb, *Vb;
    if (it < 1024) {
      int item = it;
      if (nblk == 256) { const int xcd = it & 7, i = (it >> 3) & 31, j = it >> 8; item = ((j * 16 + xcd * 2 + (i >> 4)) << 4) | (i & 15); }
      bh = item >> 4; qb = item & 15; L = LS; NK = NKS;
      Qb = Qg + Q_S_OFF + (size_t)bh * LS * 192; Kb = Kg + K_S_OFF + (size_t)bh * NKS * 192; Vb = Vtg + VT_S_OFF + (size_t)bh * 128 * NKS;
      tokbase = NTP + (bh >> 3) * LS;
    } else {
      bh = it - 1024; qb = 0; L = LP; NK = LP;
      Qb = Qg + (size_t)bh * LP * 192; Kb = Kg + (size_t)bh * LP * 192; Vb = Vtg + (size_t)bh * 128 * LP;
      tokbase = (bh >> 3) * LP;
    }
    const int h = bh & 7;
    const int qrow = qb * 256 + wave * 32 + r;
    uint4 pkA0, pkA1, pkA2, pvA0, pvA1, pkB0, pkB1, pkB2, pvB0, pvB1;
    const int vrow0 = tid >> 3, vpart = tid & 7;
#define ATT_GLOAD(S, t_)                                                                   \
  {                                                                                         \
    const u16* ksrc = Kb + (size_t)(t_) * 64 * 192 + (size_t)tid * 8;                       \
    pk##S##0 = *(const uint4*)(ksrc);                                                       \
    pk##S##1 = *(const uint4*)(ksrc + 512 * 8);                                             \
    pk##S##2 = *(const uint4*)(ksrc + 1024 * 8);                                            \
    const u16* vsrc = Vb + (size_t)vrow0 * NK + (t_) * 64 + vpart * 8;                      \
    pv##S##0 = *(const uint4*)(vsrc);                                                       \
    pv##S##1 = *(const uint4*)(vsrc + (size_t)64 * NK);                                     \
  }
#define ATT_SWRITE(S, st_)                                                                 \
  {                                                                                         \
    char* sb = smem + (st_) * ST_B;                                                         \
    *(uint4*)(sb + (tid / 24) * 400 + (tid % 24) * 16) = pk##S##0;                          \
    *(uint4*)(sb + ((tid + 512) / 24) * 400 + ((tid + 512) % 24) * 16) = pk##S##1;          \
    *(uint4*)(sb + ((tid + 1024) / 24) * 400 + ((tid + 1024) % 24) * 16) = pk##S##2;        \
    char* d = sb + KT_B + vrow0 * 144 + vpart * 16;                                         \
    *(uint4*)d = pv##S##0;                                                                  \
    *(uint4*)(d + 64 * 144) = pv##S##1;                                                     \
  }
    const int ntiles = NK >> 6;
    ATT_GLOAD(A, 0);
    ATT_GLOAD(B, 1);
    bf16x8 qf[12];
    {
      const u16* qp = Qb + (size_t)qrow * 192 + hh * 8;
#pragma unroll
      for (int s = 0; s < 12; ++s) qf[s] = *(const bf16x8*)(qp + s * 16);
      const float rq = ((const float*)(ws + WS_QF))[((size_t)tokbase + qrow) * 8 + h];
#pragma unroll
      for (int s = 0; s < 12; ++s) {
        const uint4 u = __builtin_bit_cast(uint4, qf[s]);
        uint4 o;
        o.x = pack2(bflo(u.x) * rq, bfhi(u.x) * rq); o.y = pack2(bflo(u.y) * rq, bfhi(u.y) * rq);
        o.z = pack2(bflo(u.z) * rq, bfhi(u.z) * rq); o.w = pack2(bflo(u.w) * rq, bfhi(u.w) * rq);
        qf[s] = __builtin_bit_cast(bf16x8, o);
      }
    }
    f32x16 ot[4];
#pragma unroll
    for (int e = 0; e < 4; ++e) zero16(ot[e]);
    float m = -1e30f, l = 0.f;
    ATT_SWRITE(A, 0);
    __syncthreads();
    if (2 < ntiles) ATT_GLOAD(A, 2);
    if (wave >= 4) __builtin_amdgcn_s_setprio(1);
    for (int t2 = 0; t2 < ntiles; t2 += 2) {
      {
        const int t = t2;
        ATT_SWRITE(B, 1);
        if (t + 3 < ntiles) ATT_GLOAD(B, t + 3);
      const char* sK = smem + (t & 1) * ST_B + r * 400 + hh * 16;
      const char* sV = smem + (t & 1) * ST_B + KT_B + r * 144 + hh * 16;
      f32x16 st[2];
      zero16(st[0]);
      zero16(st[1]);
#pragma unroll
      for (int s = 0; s < 12; ++s) {
        const bf16x8 k0 = *(const bf16x8*)(sK + s * 32);
        const bf16x8 k1 = *(const bf16x8*)(sK + 32 * 400 + s * 32);
        st[0] = MFMA(k0, qf[s], st[0]);
        st[1] = MFMA(k1, qf[s], st[1]);
      }
      float mx = st[0][0];
#pragma unroll
      for (int g = 1; g < 16; ++g) mx = fmaxf(mx, st[0][g]);
#pragma unroll
      for (int g = 0; g < 16; ++g) mx = fmaxf(mx, st[1][g]);
      mx = fmaxf(mx, shx(mx, 32, tid));
      if (__builtin_amdgcn_ballot_w64(mx > m + 11.5f) != 0ull) {
        const float mnew = fmaxf(m, mx);
        const float alpha = fexp2(m - mnew);
        m = mnew;
        l *= alpha;
#pragma unroll
        for (int e = 0; e < 4; ++e)
#pragma unroll
          for (int g = 0; g < 16; ++g) ot[e][g] *= alpha;
      }
      float psum = 0.f;
#pragma unroll
      for (int b2 = 0; b2 < 2; ++b2)
#pragma unroll
        for (int g = 0; g < 16; ++g) {
          const float e = fexp2(st[b2][g] - m);
          st[b2][g] = e;
          psum += e;
        }
      l += psum;
#pragma unroll
      for (int s4 = 0; s4 < 4; ++s4) {
        const int mb = s4 >> 1, sub = s4 & 1;
        uint4 pp;
        pp.x = pack2(st[mb][8 * sub + 0], st[mb][8 * sub + 1]);
        pp.y = pack2(st[mb][8 * sub + 2], st[mb][8 * sub + 3]);
        pp.z = pack2(st[mb][8 * sub + 4], st[mb][8 * sub + 5]);
        pp.w = pack2(st[mb][8 * sub + 6], st[mb][8 * sub + 7]);
        const bf16x8 pfrag = __builtin_bit_cast(bf16x8, pp);
#pragma unroll
        for (int eb = 0; eb < 4; ++eb) {
          const uint4 vv = *(const uint4*)(sV + eb * 32 * 144 + s4 * 32);
          ot[eb] = MFMA(__builtin_bit_cast(bf16x8, vv), pfrag, ot[eb]);
        }
      }
        __syncthreads();
      }
      {
        const int t = t2 + 1;
        if (t + 1 < ntiles) ATT_SWRITE(A, 0);
        if (t + 3 < ntiles) ATT_GLOAD(A, t + 3);
      const char* sK = smem + (t & 1) * ST_B + r * 400 + hh * 16;
      const char* sV = smem + (t & 1) * ST_B + KT_B + r * 144 + hh * 16;
      f32x16 st[2];
      zero16(st[0]);
      zero16(st[1]);
#pragma unroll
      for (int s = 0; s < 12; ++s) {
        const bf16x8 k0 = *(const bf16x8*)(sK + s * 32);
        const bf16x8 k1 = *(const bf16x8*)(sK + 32 * 400 + s * 32);
        st[0] = MFMA(k0, qf[s], st[0]);
        st[1] = MFMA(k1, qf[s], st[1]);
      }
      float mx = st[0][0];
#pragma unroll
      for (int g = 1; g < 16; ++g) mx = fmaxf(mx, st[0][g]);
#pragma unroll
      for (int g = 0; g < 16; ++g) mx = fmaxf(mx, st[1][g]);
      mx = fmaxf(mx, shx(mx, 32, tid));
      if (__builtin_amdgcn_ballot_w64(mx > m + 11.5f) != 0ull) {
        const float mnew = fmaxf(m, mx);
        const float alpha = fexp2(m - mnew);
        m = mnew;
        l *= alpha;
#pragma unroll
        for (int e = 0; e < 4; ++e)
#pragma unroll
          for (int g = 0; g < 16; ++g) ot[e][g] *= alpha;
      }
      float psum = 0.f;
#pragma unroll
      for (int b2 = 0; b2 < 2; ++b2)
#pragma unroll
        for (int g = 0; g < 16; ++g) {
          const float e = fexp2(st[b2][g] - m);
          st[b2][g] = e;
          psum += e;
        }
      l += psum;
#pragma unroll
      for (int s4 = 0; s4 < 4; ++s4) {
        const int mb = s4 >> 1, sub = s4 & 1;
        uint4 pp;
        pp.x = pack2(st[mb][8 * sub + 0], st[mb][8 * sub + 1]);
        pp.y = pack2(st[mb][8 * sub + 2], st[mb][8 * sub + 3]);
        pp.z = pack2(st[mb][8 * sub + 4], st[mb][8 * sub + 5]);
        pp.w = pack2(st[mb][8 * sub + 6], st[mb][8 * sub + 7]);
        const bf16x8 pfrag = __builtin_bit_cast(bf16x8, pp);
#pragma unroll
        for (int eb = 0; eb < 4; ++eb) {
          const uint4 vv = *(const uint4*)(sV + eb * 32 * 144 + s4 * 32);
          ot[eb] = MFMA(__builtin_bit_cast(bf16x8, vv), pfrag, ot[eb]);
        }
      }
        __syncthreads();
      }
    }
    __builtin_amdgcn_s_setprio(0);
    const float ltot = l + shx(l, 32, tid);
    const float inv = 1.f / ltot;
#pragma unroll
    for (int eb = 0; eb < 4; ++eb)
#pragma unroll
      for (int q4 = 0; q4 < 4; ++q4) {
        uint2 o;
        o.x = pack2(ot[eb][4 * q4] * inv, ot[eb][4 * q4 + 1] * inv);
        o.y = pack2(ot[eb][4 * q4 + 2] * inv, ot[eb][4 * q4 + 3] * inv);
        *(uint2*)(smem + (wave * 32 + r) * 272 + (eb * 32 + 8 * q4 + 4 * hh) * 2) = o;
      }
    __syncthreads();
    {
      const int part = tid & 15, row0 = tid >> 4;
      const size_t tokb = (size_t)tokbase + qb * 256;
#pragma unroll 4
      for (int c = 0; c < 8; ++c) {
        const int row = row0 + c * 32;
        const uint4 ov = *(const uint4*)(smem + row * 272 + part * 16);
        const uint4 gg = *(const uint4*)(G + (tokb + row) * 2048 + h * 128 + part * 8);
        uint4 o;
        o.x = pack2(bflo(ov.x) * silu(bflo(gg.x)), bfhi(ov.x) * silu(bfhi(gg.x)));
        o.y = pack2(bflo(ov.y) * silu(bflo(gg.y)), bfhi(ov.y) * silu(bfhi(gg.y)));
        o.z = pack2(bflo(ov.z) * silu(bflo(gg.z)), bfhi(ov.z) * silu(bfhi(gg.z)));
        o.w = pack2(bflo(ov.w) * silu(bflo(gg.w)), bfhi(ov.w) * silu(bfhi(gg.w)));
        *(uint4*)(mixA + (tokb + row) * 1024 + h * 128 + part * 8) = o;
      }
    }
    __syncthreads();
  }
}

DI void phase_ret(const int wave_s, const Params& p, char* smem) {
  unsigned char* ws = launder_p(p.ws);
  const u16* RQ = (const u16*)(ws + WS_RQ);
  const u16* RK = (const u16*)(ws + WS_RK);
  const u16* RKt = (const u16*)(ws + WS_RKT);
  const u16* RVt = (const u16*)(ws + WS_RVT);
  const int tid = launder_v(launder_s(wave_s) * 64 + (int)__builtin_amdgcn_mbcnt_hi(launder_s(-1), __builtin_amdgcn_mbcnt_lo(-1, 0))), lane = tid & 63, wave = __builtin_amdgcn_readfirstlane(tid >> 6);
  const int r_ = lane & 31, hh_ = lane >> 5;
  constexpr int RS = 272;
  char* sQ = smem;
  char* sK = smem + 128 * RS;
  char* sKt = smem + 2 * 128 * RS;
  char* sVt = smem + 3 * 128 * RS;
  char* sSt = sVt + 64 * RS;
  float* sKd = (float*)(sSt + 64 * RS);
  float* sQd = sKd + 128;
  float* sDd = sQd + 128;
  float* sInv = sDd + 128;
  const int ib = wave >> 1, eb = wave & 1;
  for (int item = launder_s(blockIdx.x); item < 256 + 1024; item += gridDim.x) {
    int bb, hd, dir, dvs, L, tokbase;
    size_t rkt_off, rvt_off;
    bool sample;
    if (item < 256) {
      int it2 = item;
      if (gridDim.x == 256) { const int xcd = item & 7, i = item >> 3; it2 = ((xcd * 4 + (i >> 3)) << 3) | (i & 7); }
      sample = true; dvs = it2 & 3; dir = (it2 >> 2) & 1; hd = (it2 >> 3) & 3; bb = it2 >> 5; L = LS; tokbase = NTP + bb * LS;
      rkt_off = RKT_S_OFF + (size_t)(bb * 4 + hd) * 128 * LS; rvt_off = RVT_S_OFF + ((size_t)(bb * 4 + hd) * 256 + dvs * 64) * LS;
    } else {
      int it = item - 256;
      if (gridDim.x == 256) { const int xcd = it & 7, i = (it >> 3) & 31, j = it >> 8; it = ((j * 32 + xcd * 4 + (i >> 3)) << 3) | (i & 7); }
      sample = false; dvs = it & 3; dir = (it >> 2) & 1; hd = (it >> 3) & 3; bb = it >> 5; L = LP; tokbase = bb * LP;
      rkt_off = (size_t)(bb * 4 + hd) * 128 * LP; rvt_off = ((size_t)(bb * 4 + hd) * 256 + dvs * 64) * LP;
    }
    const float lg = -__expf(dir ? p.ld_bwd[hd] : p.ld_fwd[hd]);
    const float lg2 = lg * LOG2E;
    const float cdec = fexp2(128.f * lg2);
    if (tid < 128) {
      sKd[tid] = fexp2((float)(dir ? tid : 127 - tid) * lg2);
      sQd[tid] = fexp2((float)(dir ? 128 - tid : tid + 1) * lg2);
      sDd[tid] = fexp2((float)tid * lg2);
      if (tid < 32) sInv[tid] = fexp2(-(float)tid * lg2);
    }
    __syncthreads();
    u16* O = (u16*)(ws + (dir ? WS_OB : WS_OF));
    f32x16 S;
    {
    const int r = r_, hh = hh_;
    if (sample) {
      const float* s0 = (dir ? p.st_bwd : p.st_fwd) + (size_t)(bb * 4 + hd) * 128 * 256 + dvs * 64 + eb * 32 + r;
#pragma unroll
      for (int g = 0; g < 16; ++g) S[g] = s0[(size_t)(ib * 32 + crow(g, hh)) * 256];
    } else {
      zero16(S);
    }
    }
    const int n = L >> 7;
    const int row0_ = tid >> 4, part_ = tid & 15;
    uint4 pq0, pq1, pq2, pq3, pk0, pk1, pk2, pk3;
#define RET_LOADQK(c_)                                                               \
  {                                                                                   \
    const u16* bq = RQ + (size_t)(tokbase + (c_) * 128) * 512 + hd * 128;             \
    const u16* bk = RK + (size_t)(tokbase + (c_) * 128) * 512 + hd * 128;             \
    const unsigned o_ = (unsigned)(row0 * 512 + part * 8);                            \
    pq0 = *(const uint4*)(bq + o_); pq1 = *(const uint4*)(bq + o_ + 32 * 512);        \
    pq2 = *(const uint4*)(bq + o_ + 64 * 512); pq3 = *(const uint4*)(bq + o_ + 96 * 512); \
    pk0 = *(const uint4*)(bk + o_); pk1 = *(const uint4*)(bk + o_ + 32 * 512);        \
    pk2 = *(const uint4*)(bk + o_ + 64 * 512); pk3 = *(const uint4*)(bk + o_ + 96 * 512); \
  }
    { const int row0 = row0_, part = part_; RET_LOADQK(dir ? (n - 1) : 0); }
    for (int step = 0; step < n; ++step) {
      const int r = launder_v(r_), hh = launder_v(hh_), row0 = launder_v(row0_), part = launder_v(part_);
      const int c = dir ? (n - 1 - step) : step;
      const int tok0 = tokbase + c * 128;
#pragma unroll
      for (int q4 = 0; q4 < 4; ++q4) {
        uint2 o;
        o.x = pack2(S[4 * q4], S[4 * q4 + 1]); o.y = pack2(S[4 * q4 + 2], S[4 * q4 + 3]);
        *(uint2*)(sSt + (eb * 32 + r) * RS + (ib * 32 + 8 * q4 + 4 * hh) * 2) = o;
      }
      {
        char* dq = sQ + row0 * RS + part * 16;
        char* dk = sK + row0 * RS + part * 16;
        *(uint4*)(dq) = pq0; *(uint4*)(dq + 32 * RS) = pq1; *(uint4*)(dq + 64 * RS) = pq2; *(uint4*)(dq + 96 * RS) = pq3;
        *(uint4*)(dk) = pk0; *(uint4*)(dk + 32 * RS) = pk1; *(uint4*)(dk + 64 * RS) = pk2; *(uint4*)(dk + 96 * RS) = pk3;
      }
      const u16* bkt = RKt + rkt_off + c * 128;
      const u16* bvt = RVt + rvt_off + c * 128;
      const unsigned ot_ = (unsigned)(row0 * L + part * 8);
      uint4 kt0 = *(const uint4*)(bkt + ot_), kt1 = *(const uint4*)(bkt + ot_ + 32 * L);
      uint4 kt2 = *(const uint4*)(bkt + ot_ + 64 * L), kt3 = *(const uint4*)(bkt + ot_ + 96 * L);
      const uint4 vt0 = *(const uint4*)(bvt + ot_), vt1 = *(const uint4*)(bvt + ot_ + 32 * L);
      __syncthreads();
      f32x16 av[2];
#pragma unroll
      for (int jj = 0; jj < 2; ++jj) {
        const int jb = 2 * eb + jj;
        const bool skip = dir ? (jb < ib) : (jb > ib);
        if (skip) {
          zero16(av[jj]);
        } else {
          const char* ka = sK + (jb * 32 + r) * RS + hh * 16;
          const char* qa = sQ + (ib * 32 + r) * RS + hh * 16;
          const f32x16 zc = {0.f, 0.f, 0.f, 0.f, 0.f, 0.f, 0.f, 0.f, 0.f, 0.f, 0.f, 0.f, 0.f, 0.f, 0.f, 0.f};
          av[jj] = MFMA(*(const bf16x8*)(ka), *(const bf16x8*)(qa), zc);
#pragma unroll
          for (int s = 1; s < 8; ++s) av[jj] = MFMA(*(const bf16x8*)(ka + s * 32), *(const bf16x8*)(qa + s * 32), av[jj]);
          const int dblk = dir ? (jb - ib) : (ib - jb);
          const float lf = dir ? sInv[r] : sDd[dblk * 32 + r];
          const float* ct = dir ? (sDd + dblk * 32 + 4 * hh) : (sInv + 4 * hh);
#pragma unroll
          for (int q4 = 0; q4 < 4; ++q4) {
            const float4 c4 = *(const float4*)(ct + 8 * q4);
            av[jj][4 * q4 + 0] *= lf * c4.x;
            av[jj][4 * q4 + 1] *= lf * c4.y;
            av[jj][4 * q4 + 2] *= lf * c4.z;
            av[jj][4 * q4 + 3] *= lf * c4.w;
          }
          if (dblk == 0) {
#pragma unroll
            for (int g = 0; g < 16; ++g) {
              const int jl = crow(g, hh);
              const bool keep = dir ? (jl > r) : (jl <= r);
              av[jj][g] = keep ? av[jj][g] : 0.f;
            }
          }
        }
      }
      __syncthreads();
#pragma unroll
      for (int jj = 0; jj < 2; ++jj) {
        const int jb = 2 * eb + jj;
#pragma unroll
        for (int q4 = 0; q4 < 4; ++q4) {
          uint2 o;
          o.x = pack2(av[jj][4 * q4], av[jj][4 * q4 + 1]); o.y = pack2(av[jj][4 * q4 + 2], av[jj][4 * q4 + 3]);
          *(uint2*)(sK + (ib * 32 + r) * RS + (jb * 32 + 8 * q4 + 4 * hh) * 2) = o;
        }
      }
      {
        const float4 d0 = *(const float4*)(sKd + part * 8), d1 = *(const float4*)(sKd + part * 8 + 4);
#define RET_SCALE(kt)                                                                   \
  kt.x = pack2(bflo(kt.x) * d0.x, bfhi(kt.x) * d0.y); kt.y = pack2(bflo(kt.y) * d0.z, bfhi(kt.y) * d0.w); \
  kt.z = pack2(bflo(kt.z) * d1.x, bfhi(kt.z) * d1.y); kt.w = pack2(bflo(kt.w) * d1.z, bfhi(kt.w) * d1.w);
        RET_SCALE(kt0) RET_SCALE(kt1) RET_SCALE(kt2) RET_SCALE(kt3)
        char* dkt = sKt + row0 * RS + part * 16;
        *(uint4*)(dkt) = kt0; *(uint4*)(dkt + 32 * RS) = kt1; *(uint4*)(dkt + 64 * RS) = kt2; *(uint4*)(dkt + 96 * RS) = kt3;
        char* dvt = sVt + row0 * RS + part * 16;
        *(uint4*)(dvt) = vt0; *(uint4*)(dvt + 32 * RS) = vt1;
      }
      if (step + 1 < n) RET_LOADQK(dir ? (n - 2 - step) : (step + 1));
      __syncthreads();
      {
        f32x16 a1, a2;
        zero16(a1);
        const char* aa = sK + (ib * 32 + r) * RS + hh * 16;
        const char* va = sVt + (eb * 32 + r) * RS + hh * 16;
        const char* qa = sQ + (ib * 32 + r) * RS + hh * 16;
        const char* sa = sSt + (eb * 32 + r) * RS + hh * 16;
        const int slo = dir ? 2 * ib : 0, shi = dir ? 8 : 2 * ib + 2;
#pragma unroll
        for (int s = 0; s < 8; ++s)
          if (s >= slo && s < shi) a1 = MFMA(*(const bf16x8*)(aa + s * 32), *(const bf16x8*)(va + s * 32), a1);
        {
          const f32x16 zc = {0.f, 0.f, 0.f, 0.f, 0.f, 0.f, 0.f, 0.f, 0.f, 0.f, 0.f, 0.f, 0.f, 0.f, 0.f, 0.f};
          a2 = MFMA(*(const bf16x8*)(qa), *(const bf16x8*)(sa), zc);
        }
#pragma unroll
        for (int s = 1; s < 8; ++s) a2 = MFMA(*(const bf16x8*)(qa + s * 32), *(const bf16x8*)(sa + s * 32), a2);
        u16* od = O + (size_t)tok0 * 1024 + hd * 256 + dvs * 64;
        const int r2 = launder_v(r), hh2 = launder_v(hh);
#pragma unroll
        for (int q4 = 0; q4 < 4; ++q4) {
          const int i0 = ib * 32 + 8 * q4 + 4 * hh2;
          const float4 qd = *(const float4*)(sQd + i0);
          const unsigned o0 = (unsigned)(i0 * 1024 + eb * 32 + r2);
          od[o0] = f2bf(a1[4 * q4 + 0] + qd.x * a2[4 * q4 + 0]);
          od[o0 + 1024] = f2bf(a1[4 * q4 + 1] + qd.y * a2[4 * q4 + 1]);
          od[o0 + 2048] = f2bf(a1[4 * q4 + 2] + qd.z * a2[4 * q4 + 2]);
          od[o0 + 3072] = f2bf(a1[4 * q4 + 3] + qd.w * a2[4 * q4 + 3]);
        }
      }
      {
#pragma unroll
        for (int g = 0; g < 16; ++g) S[g] *= cdec;
        const char* ka = sKt + (ib * 32 + r) * RS + hh * 16;
        const char* va = sVt + (eb * 32 + r) * RS + hh * 16;
#pragma unroll
        for (int s = 0; s < 8; ++s) S = MFMA(*(const bf16x8*)(ka + s * 32), *(const bf16x8*)(va + s * 32), S);
      }
      __syncthreads();
    }
    if (!sample) {
      const int r = r_, hh = hh_;
      float* sd = p.out + (dir ? OUT_SB : OUT_SF) + (size_t)(bb * 4 + hd) * 128 * 256 + dvs * 64 + eb * 32 + r;
#pragma unroll
      for (int g = 0; g < 16; ++g) sd[(size_t)(ib * 32 + crow(g, hh)) * 256] = S[g];
    }
  }
}

DI void phase6(const int wave_s, const Params& p) {
  unsigned char* ws = launder_p(p.ws);
  const u16* OF = (const u16*)(ws + WS_OF);
  u16* MR = (u16*)(ws + WS_MIXR);
  const u16* OB = (const u16*)(ws + WS_OB);
  const u16* G = (const u16*)(ws + WS_G);
  const int tid = launder_v(launder_s(wave_s) * 64 + (int)__builtin_amdgcn_mbcnt_hi(launder_s(-1), __builtin_amdgcn_mbcnt_lo(-1, 0)));
  const int lane = tid & 63, wave = tid >> 6;
  for (int it = launder_s(blockIdx.x) * 8 + wave; it < NT * 4; it += gridDim.x * 8) {
    const int tok = it >> 2, hd = it & 3;
    const size_t off = (size_t)tok * 1024 + hd * 256 + lane * 4;
    const uint2 a = *(const uint2*)(OF + off);
    const uint2 b = *(const uint2*)(OB + off);
    const uint2 g = *(const uint2*)(G + (size_t)tok * 2048 + 1024 + hd * 256 + lane * 4);
    const float4 w = *(const float4*)(p.gn_w + hd * 256 + lane * 4);
    const float v0 = bflo(a.x) + bflo(b.x), v1 = bfhi(a.x) + bfhi(b.x), v2 = bflo(a.y) + bflo(b.y), v3 = bfhi(a.y) + bfhi(b.y);
    float ss = v0 * v0 + v1 * v1 + v2 * v2 + v3 * v3;
#pragma unroll
    for (int o = 32; o >= 1; o >>= 1) ss += shx(ss, o, tid);
    const float rinv = rsqrtf(ss * (1.f / 256.f) + EPSF);
    uint2 o;
    o.x = pack2(v0 * rinv * w.x * silu(bflo(g.x)), v1 * rinv * w.y * silu(bfhi(g.x)));
    o.y = pack2(v2 * rinv * w.z * silu(bflo(g.y)), v3 * rinv * w.w * silu(bfhi(g.y)));
    *(uint2*)(MR + off) = o;
  }
}

DI void phase7(const int wave_s, const Params& p, char* smem) {
  unsigned char* ws = launder_p(p.ws);
  const u16* mixA = (const u16*)(ws + WS_MIXA);
  const u16* mixR = (const u16*)(ws + WS_MIXR);
  const u16* WoT = (const u16*)(ws + WS_WOT);
  const float* mod = (const float*)(ws + WS_MOD);
  const int tid = launder_v(launder_s(wave_s) * 64 + (int)__builtin_amdgcn_mbcnt_hi(launder_s(-1), __builtin_amdgcn_mbcnt_lo(-1, 0)));
  const int lane = tid & 63, wave = tid >> 6;
  const int r = lane & 31, hh = lane >> 5;
  const int xcd = launder_s(blockIdx.x) & 7, bi = launder_s(blockIdx.x) >> 3, nb = gridDim.x >> 3;
  if (bi >= nb) return;
  for (int pos = xcd * 160 + bi; pos < (xcd + 1) * 160; pos += nb) {
    const int patch = pos >> 5, i = pos & 31;
    const int mt = (patch >> 1) * 8 + (i & 7), nt = (patch & 1) * 4 + (i >> 3);
    const int tok0 = mt * 256, n0 = nt * 256;
    f32x4 acc[2][2][4][2];
    gemm8p(acc, WoT + (size_t)n0 * D, D, mixA + (size_t)tok0 * 1024, mixR + (size_t)tok0 * 1024, 1024, 1024, 32, smem, tid);
    const int wr = wave >> 2, wc = wave & 3, fr = lane & 15, fq = lane >> 4;
    const int mrow = (tok0 < NTP) ? 8 : ((tok0 - NTP) >> 12);
    const float* gate = mod + mrow * 6144 + 4096 + n0 + wr * 64 + fq * 4;
#pragma unroll
    for (int a = 0; a < 2; ++a)
#pragma unroll
      for (int m = 0; m < 4; ++m) {
        const f32x4 g4 = *(const f32x4*)(gate + a * 128 + m * 16);
#pragma unroll
        for (int b = 0; b < 2; ++b)
#pragma unroll
          for (int n = 0; n < 2; ++n) {
            const f32x4 v = acc[a][b][m][n] * g4;
            uint2 o;
            o.x = pack2(v[0], v[1]); o.y = pack2(v[2], v[3]);
            *(uint2*)(smem + (b * 128 + wc * 32 + n * 16 + fr) * 528 + (a * 128 + wr * 64 + m * 16 + fq * 4) * 2) = o;
          }
      }
    const int part = tid & 31, row0 = tid >> 5;
    const float* xb = ((tok0 < NTP) ? (p.x_prompt + (size_t)tok0 * D) : (p.x_sample + (size_t)(tok0 - NTP) * D)) + n0 + part * 8;
    float4 xp0[4], xp1[4];
#pragma unroll
    for (int c = 0; c < 4; ++c) {
      xp0[c] = *(const float4*)(xb + (size_t)(row0 + c * 16) * D);
      xp1[c] = *(const float4*)(xb + (size_t)(row0 + c * 16) * D + 4);
    }
    __syncthreads();
    {
      float* ob = p.out + OUT_YP + (size_t)tok0 * D + n0 + part * 8;
#pragma unroll
      for (int c = 0; c < 4; ++c) {
        const int row = row0 + c * 16;
        const uint4 dv = *(const uint4*)(smem + row * 528 + part * 16);
        const float4 x0 = xp0[c], x1 = xp1[c];
        float4 o0, o1;
        o0.x = x0.x + bflo(dv.x); o0.y = x0.y + bfhi(dv.x); o0.z = x0.z + bflo(dv.y); o0.w = x0.w + bfhi(dv.y);
        o1.x = x1.x + bflo(dv.z); o1.y = x1.y + bfhi(dv.z); o1.z = x1.z + bflo(dv.w); o1.w = x1.w + bfhi(dv.w);
        *(float4*)(ob + (size_t)row * D) = o0;
        *(float4*)(ob + (size_t)row * D + 4) = o1;
      }
#pragma unroll 4
      for (int c = 4; c < 16; ++c) {
        const int row = row0 + c * 16;
        const uint4 dv = *(const uint4*)(smem + row * 528 + part * 16);
        const float4 x0 = *(const float4*)(xb + (size_t)row * D), x1 = *(const float4*)(xb + (size_t)row * D + 4);
        float4 o0, o1;
        o0.x = x0.x + bflo(dv.x); o0.y = x0.y + bfhi(dv.x); o0.z = x0.z + bflo(dv.y); o0.w = x0.w + bfhi(dv.y);
        o1.x = x1.x + bflo(dv.z); o1.y = x1.y + bfhi(dv.z); o1.z = x1.z + bflo(dv.w); o1.w = x1.w + bfhi(dv.w);
        *(float4*)(ob + (size_t)row * D) = o0;
        *(float4*)(ob + (size_t)row * D + 4) = o1;
      }
    }
    __syncthreads();
  }
}

#ifndef PROBE_REP_P0
#define PROBE_REP_P0 0
#endif
#ifndef PROBE_REP_P1
#define PROBE_REP_P1 0
#endif
#ifndef PROBE_REP_P3
#define PROBE_REP_P3 0
#endif
#ifndef PROBE_REP_P6
#define PROBE_REP_P6 0
#endif
#ifndef PROBE_REP_ATTN
#define PROBE_REP_ATTN 0
#endif
#ifndef PROBE_REP_RET
#define PROBE_REP_RET 0
#endif
#ifndef PROBE_REP_G1
#define PROBE_REP_G1 0
#endif
#ifndef PROBE_REP_G2
#define PROBE_REP_G2 0
#endif
#define XB_TMO 128
#define XB_XCNT(j) (256 + 64 * (j))
#define XB_XSUB(j) (1280 + 64 * (j))
#define XB_XGEN(j) (2304 + 64 * (j))
#define XB_TOP 3328
#define XB_TOPGEN 3392
#define XB_SPIN_CAP (1u << 22)
DI unsigned xb_ld(unsigned* q) { return __hip_atomic_load(q, __ATOMIC_RELAXED, __HIP_MEMORY_SCOPE_AGENT); }
DI unsigned xb_add(unsigned* q, unsigned v) { return __hip_atomic_fetch_add(q, v, __ATOMIC_RELAXED, __HIP_MEMORY_SCOPE_AGENT); }
DI unsigned xb_xcc_id() { return (unsigned)__builtin_amdgcn_s_getreg((3 << 11) | 20) & 0xFu; }
#define XB_SPIN(cond, bar)                                                                  \
  do {                                                                                       \
    unsigned _sp = 0;                                                                        \
    while (cond) {                                                                           \
      __builtin_amdgcn_s_sleep(1);                                                           \
      if ((++_sp & 255u) == 0u) {                                                            \
        if (xb_ld(&(bar)[XB_TMO])) break;                                                    \
        if (_sp > XB_SPIN_CAP) { atomicAdd(&(bar)[XB_TMO], 1u); break; }                     \
      }                                                                                      \
    }                                                                                        \
  } while (0)
DI void xb_complete(unsigned* bar, unsigned x, unsigned G, unsigned& nloc, unsigned& nx) {
  unsigned sum, cnt, mine, sp = 0u;
  for (;;) {
    sum = 0u; cnt = 0u; mine = 0u;
#pragma unroll
    for (unsigned j = 0; j < 16; ++j) { const unsigned c = xb_ld(&bar[XB_XCNT(j)]); sum += c; cnt += (c > 0u) ? 1u : 0u; mine = (j == x) ? c : mine; }
    if (sum == G) break;
    __builtin_amdgcn_s_sleep(1);
    if ((++sp & 255u) == 0u) { if (xb_ld(&bar[XB_TMO])) break; if (sp > XB_SPIN_CAP) { atomicAdd(&bar[XB_TMO], 1u); break; } }
  }
  nloc = mine > 0u ? mine : 1u; nx = cnt > 0u ? cnt : 1u;
}
DI void xcd_barrier(unsigned* bar, const unsigned x, volatile LAS unsigned* st, const bool t0) {
  asm volatile("s_waitcnt vmcnt(0)" ::: "memory");
  __syncthreads();
  if (t0) {
    __builtin_amdgcn_s_waitcnt(0);
    unsigned nloc = st[0], nx = st[1];
    if (nloc == 0u) { xb_complete(bar, x, gridDim.x, nloc, nx); st[0] = nloc; st[1] = nx; }
    const unsigned old = xb_add(&bar[XB_XSUB(x)], 1u);
    const unsigned gen = old / nloc;
    if (old + 1u == (gen + 1u) * nloc) {
      __builtin_amdgcn_fence(__ATOMIC_RELEASE, "agent");
      asm volatile("s_waitcnt vmcnt(0)" ::: "memory");
      const unsigned og = xb_add(&bar[XB_TOP], 1u);
      const unsigned tg = og / nx;
      if (og + 1u == (tg + 1u) * nx) xb_add(&bar[XB_TOPGEN], 1u);
      else XB_SPIN(xb_ld(&bar[XB_TOPGEN]) == tg, bar);
      __builtin_amdgcn_fence(__ATOMIC_ACQUIRE, "agent");
      xb_add(&bar[XB_XGEN(x)], 1u);
      asm volatile("s_waitcnt vmcnt(0)" ::: "memory");
    } else {
      XB_SPIN(xb_ld(&bar[XB_XGEN(x)]) == gen, bar);
      __builtin_amdgcn_fence(__ATOMIC_ACQUIRE, "agent");
      asm volatile("s_waitcnt vmcnt(0)" ::: "memory");
    }
  }
  __syncthreads();
}

__global__ void __launch_bounds__(512) fwd_megakernel(Params p) {
  extern __shared__ __attribute__((aligned(16))) char smem[];
  cg::grid_group grid = cg::this_grid();
  const int wave_s = __builtin_amdgcn_readfirstlane((int)(threadIdx.x >> 6));
  unsigned* xbar = (unsigned*)(p.ws + WS_BAR);
  volatile LAS unsigned* xst = (volatile LAS unsigned*)((LAS char*)smem + (LDS_BYTES - 16));
  const unsigned xcc = xb_xcc_id();
  if (threadIdx.x == 0) { xst[0] = 0u; xst[1] = 0u; xst[2] = 0u; xst[3] = 0u; (void)xb_add(&xbar[XB_XCNT(xcc)], 1u); }
  __syncthreads();
  const bool multi = (p.phase_hi - p.phase_lo) > 1;
  for (int ph = p.phase_lo; ph < p.phase_hi; ++ph) {
    if (ph == 0) { phase0(wave_s, p, smem, false); if (PROBE_REP_P0) { __syncthreads(); phase0(wave_s, p, smem, true); } }
    else if (ph == 1) { phase1(wave_s, p); if (PROBE_REP_P1) { __syncthreads(); phase1(wave_s, p); } }
    else if (ph == 2) { phase2(wave_s, p, smem); if (PROBE_REP_G1) { __syncthreads(); phase2(wave_s, p, smem); } }
    else if (ph == 3) { phase3(wave_s, p, smem); if (PROBE_REP_P3) { __syncthreads(); phase3(wave_s, p, smem); } }
    else if (ph == 4) { phase_attn(wave_s, p, smem); if (PROBE_REP_ATTN) { __syncthreads(); phase_attn(wave_s, p, smem); } phase_ret(wave_s, p, smem); if (PROBE_REP_RET) { __syncthreads(); phase_ret(wave_s, p, smem); } }
    else if (ph == 5) { phase6(wave_s, p); if (PROBE_REP_P6) { __syncthreads(); phase6(wave_s, p); } }
    else { phase7(wave_s, p, smem); if (PROBE_REP_G2) { __syncthreads(); phase7(wave_s, p, smem); } }
    if (multi && ph + 1 < p.phase_hi) {
      if (p.phase_hi > 64) grid.sync();
      xcd_barrier(xbar, xcc, xst, wave_s == 0 && __builtin_amdgcn_mbcnt_hi(-1, __builtin_amdgcn_mbcnt_lo(-1, 0)) == 0);
    }
  }
}

#ifndef N_LAUNCH_MODE
#define N_LAUNCH_MODE 1
#endif

extern "C" void kernel_launch(void* const* d_in, const int* in_sizes, int n_in, void* d_out, int out_size, void* d_ws, size_t ws_size,
                              hipStream_t stream) {
  static int grid_blocks = 0;
  if (grid_blocks == 0) {
    if (n_in != 23 || ws_size < WS_END) {
      fprintf(stderr, "kernel_launch: need 23 inputs and >= %zu bytes of workspace; got %d, %zu\n", (size_t)WS_END, n_in, ws_size);
      grid_blocks = -1;
      return;
    }
    int dev = 0, cus = 0, per_cu = 0;
    hipGetDevice(&dev);
    hipDeviceGetAttribute(&cus, hipDeviceAttributeMultiprocessorCount, dev);
    hipFuncSetAttribute((const void*)fwd_megakernel, hipFuncAttributeMaxDynamicSharedMemorySize, LDS_BYTES);
    hipOccupancyMaxActiveBlocksPerMultiprocessor(&per_cu, (const void*)fwd_megakernel, 512, LDS_BYTES);
    if (per_cu < 1) { fprintf(stderr, "kernel_launch: occupancy query says %d blocks/CU\n", per_cu); per_cu = 1; }
    grid_blocks = cus;
    grid_blocks &= ~7;
    (void)hipGetLastError();
  }
  if (grid_blocks < 0) return;
  Params p{};
  p.x_prompt = (const float*)d_in[0]; p.x_sample = (const float*)d_in[1]; p.c = (const float*)d_in[2];
  p.cache_ckv = (const float*)d_in[3]; p.cache_krope = (const float*)d_in[4]; p.st_fwd = (const float*)d_in[5];
  p.st_bwd = (const float*)d_in[6]; p.c_ctx = (const float*)d_in[7]; p.norm_w = (const float*)d_in[8];
  p.w_mod = (const float*)d_in[9]; p.b_mod = (const float*)d_in[10]; p.w_in = (const float*)d_in[11];
  p.q_norm_w = (const float*)d_in[12]; p.w_uq = (const float*)d_in[13]; p.kv_norm_w = (const float*)d_in[14];
  p.w_uk = (const float*)d_in[15]; p.w_uv = (const float*)d_in[16]; p.qk_q_w = (const float*)d_in[17];
  p.qk_k_w = (const float*)d_in[18]; p.ld_fwd = (const float*)d_in[19]; p.ld_bwd = (const float*)d_in[20];
  p.gn_w = (const float*)d_in[21]; p.w_out = (const float*)d_in[22];
  p.out = (float*)d_out; p.ws = (unsigned char*)d_ws;
  hipMemsetAsync((char*)d_ws + WS_MOD, 0, WS_ROPE2D - WS_MOD, stream);
#if N_LAUNCH_MODE == 1
  p.phase_lo = 0; p.phase_hi = 7;
  void* args[] = {&p};
  hipError_t e = hipLaunchCooperativeKernel((const void*)fwd_megakernel, dim3(grid_blocks), dim3(512), args, LDS_BYTES, stream);
  if (e != hipSuccess) fprintf(stderr, "cooperative launch failed: %s (grid %d)\n", hipGetErrorString(e), grid_blocks);
#else
  for (int ph = 0; ph < 7; ++ph) {
    p.phase_lo = ph; p.phase_hi = ph + 1;
    hipLaunchKernelGGL(fwd_megakernel, dim3(grid_blocks), dim3(512), LDS_BYTES, stream, p);
  }
#endif
}
```
